# Optimizing an MI355X kernel written in HIP

```python
import jax, jax.numpy as jnp
from jax import lax
import numpy as np

D_MODEL = 4096
BATCH = 2
SEQ = 8192
DEPTH = 2

N_MIXERS = 2
N_GLA = (DEPTH + 1) // 2
N_DSA = DEPTH // 2
RMS_EPS = 1e-6

GLA_HEADS = 8
GLA_DK_TOT = D_MODEL // 2
GLA_DV_TOT = D_MODEL
GLA_DK = GLA_DK_TOT // GLA_HEADS
GLA_DV = GLA_DV_TOT // GLA_HEADS
GLA_GATE_RANK = 16
GLA_TAU = 16.0
GLA_CHUNK = 64
GLA_IN_COLS = 2 * GLA_DK_TOT + 2 * GLA_DV_TOT + GLA_GATE_RANK
GLA_SCALE = GLA_DK ** -0.5

DSA_HEADS = 64
DSA_QK_DIM = 128
DSA_V_DIM = 128
DSA_Q_RANK = 1024
DSA_KV_RANK = 512
DSA_IDX_HEADS = 64
DSA_IDX_DIM = 128
DSA_TOPK_MAX = 256
DSA_Q_BLOCK = 128
DSA_IN_COLS = DSA_Q_RANK + DSA_KV_RANK + DSA_IDX_DIM + DSA_IDX_HEADS
DSA_QUP_COLS = DSA_HEADS * DSA_QK_DIM + DSA_IDX_HEADS * DSA_IDX_DIM
DSA_SCALE = DSA_QK_DIM ** -0.5
DSA_IDX_W_SCALE = (DSA_IDX_HEADS ** -0.5) * (DSA_IDX_DIM ** -0.5)

D_FF = 11008
CONV_WIDTH = 3

kernel_name = "hybrid_gla_dsa_convffn"


def rms_norm(x, g):
    xf = x.astype(jnp.float32)
    y = xf * lax.rsqrt(jnp.mean(xf * xf, axis=-1, keepdims=True) + RMS_EPS)
    return (y * g.astype(jnp.float32)).astype(x.dtype)


def gla_mixer(h, w_in, w_a2, b_a, g_out, w_o):
    B, S, _ = h.shape
    nc = S // GLA_CHUNK
    z = h @ w_in
    q, k, v, r, a1 = jnp.split(z, [GLA_DK_TOT, 2 * GLA_DK_TOT, 2 * GLA_DK_TOT + GLA_DV_TOT,
                                   2 * GLA_DK_TOT + 2 * GLA_DV_TOT], axis=-1)
    g = jax.nn.log_sigmoid((a1 @ w_a2 + b_a).astype(jnp.float32)) / GLA_TAU

    def to_chunks(t, d):
        return t.reshape(B, nc, GLA_CHUNK, GLA_HEADS, d).transpose(1, 0, 3, 2, 4).astype(jnp.float32)

    qc = to_chunks(q, GLA_DK) * GLA_SCALE
    kc = to_chunks(k, GLA_DK)
    vc = to_chunks(v, GLA_DV)
    gc = to_chunks(g, GLA_DK)
    causal = jnp.tril(jnp.ones((GLA_CHUNK, GLA_CHUNK), dtype=bool))

    def step(state, inp):
        qi, ki, vi, gi = inp
        b = jnp.cumsum(gi, axis=-2)
        diff = b[:, :, :, None, :] - b[:, :, None, :, :]
        decay = jnp.exp(jnp.where(causal[:, :, None], diff, -jnp.inf))
        attn = jnp.einsum("bhtd,bhsd,bhtsd->bhts", qi, ki, decay)
        o = attn @ vi + jnp.einsum("bhtd,bhdv->bhtv", qi * jnp.exp(b), state)
        b_last = b[:, :, -1:, :]
        new_state = (jnp.exp(b_last[:, :, 0, :])[..., None] * state
                     + jnp.einsum("bhsd,bhsv->bhdv", ki * jnp.exp(b_last - b), vi))
        return new_state, o

    state0 = jnp.zeros((B, GLA_HEADS, GLA_DK, GLA_DV), jnp.float32)
    _, o = lax.scan(step, state0, (qc, kc, vc, gc))
    o = o.transpose(1, 0, 3, 2, 4).reshape(B, S, GLA_HEADS, GLA_DV)
    o = o * lax.rsqrt(jnp.mean(o * o, axis=-1, keepdims=True) + RMS_EPS) * g_out.astype(jnp.float32)
    o = o.reshape(B, S, GLA_DV_TOT) * jax.nn.silu(r.astype(jnp.float32))
    return o.astype(h.dtype) @ w_o


def dsa_mixer(h, w_in, g_q, g_kv, w_q_up, w_uk, w_uv, w_o):
    B, S, _ = h.shape
    topk = min(DSA_TOPK_MAX, S // 4)
    nb = S // DSA_Q_BLOCK
    z = h @ w_in
    cq, ckv, k_idx, w_idx = jnp.split(
        z, [DSA_Q_RANK, DSA_Q_RANK + DSA_KV_RANK, DSA_Q_RANK + DSA_KV_RANK + DSA_IDX_DIM], axis=-1)
    cq = rms_norm(cq, g_q)
    ckv = rms_norm(ckv, g_kv)
    k_idx = k_idx.astype(jnp.float32)
    w_idx = w_idx.astype(jnp.float32) * DSA_IDX_W_SCALE
    qq = cq @ w_q_up
    q_att, q_idx = jnp.split(qq, [DSA_HEADS * DSA_QK_DIM], axis=-1)

    def blocks(t, *tail):
        return t.reshape((B, nb, DSA_Q_BLOCK) + tail).swapaxes(0, 1)

    starts = jnp.arange(nb, dtype=jnp.int32) * DSA_Q_BLOCK
    key_pos = jnp.arange(S, dtype=jnp.int32)

    def attend(inp):
        qa, qi, wi, t0 = inp
        q_pos = t0 + jnp.arange(DSA_Q_BLOCK, dtype=jnp.int32)
        logits = jnp.einsum("bthd,bsd->bths", qi.astype(jnp.float32), k_idx)
        score = jnp.einsum("bths,bth->bts", jax.nn.relu(logits), wi)
        causal = key_pos[None, :] <= q_pos[:, None]
        score = jnp.where(causal[None], score, -jnp.inf)
        _, sel = lax.top_k(score, topk)
        valid = sel <= q_pos[None, :, None]
        c_sel = jax.vmap(lambda c, i: c[i])(ckv, sel)
        q_lat = jnp.einsum("bthd,hdc->bthc", qa, w_uk)
        s = jnp.einsum("bthc,btkc->bthk", q_lat, c_sel).astype(jnp.float32) * DSA_SCALE
        s = jnp.where(valid[:, :, None, :], s, -jnp.inf)
        p = jax.nn.softmax(s, axis=-1).astype(c_sel.dtype)
        o_lat = jnp.einsum("bthk,btkc->bthc", p, c_sel)
        return jnp.einsum("bthc,hcv->bthv", o_lat, w_uv)

    o = lax.map(attend, (blocks(q_att, DSA_HEADS, DSA_QK_DIM),
                         blocks(q_idx, DSA_IDX_HEADS, DSA_IDX_DIM),
                         blocks(w_idx, DSA_IDX_HEADS), starts))
    o = o.swapaxes(0, 1).reshape(B, S, DSA_HEADS * DSA_V_DIM)
    return o @ w_o


def causal_dwconv(u, w, b):
    S = u.shape[1]
    up = jnp.pad(u, ((0, 0), (CONV_WIDTH - 1, 0), (0, 0)))
    y = b
    for j in range(CONV_WIDTH):
        y = y + w[j] * lax.slice_in_dim(up, j, j + S, axis=1)
    return y


def conv_ffn(h, w_up, conv_w, conv_b, w_down):
    u = causal_dwconv(h @ w_up, conv_w, conv_b)
    gate, up = jnp.split(u, 2, axis=-1)
    return (jax.nn.silu(gate) * up) @ w_down


def setup_inputs(seed: int = 0) -> dict:
    key = jax.random.key(seed)
    ks = jax.random.split(key, 24)
    f32 = jnp.float32

    def nrm(k, shape, fan_in):
        return jax.random.normal(k, shape, f32) * (fan_in ** -0.5)

    def gain(k, shape):
        return 1.0 + 0.02 * jax.random.normal(k, shape, f32)

    return {
        "x": jax.random.normal(ks[0], (BATCH, SEQ, D_MODEL), f32),
        "g_mix": gain(ks[1], (DEPTH, D_MODEL)),
        "g_ffn": gain(ks[2], (DEPTH, D_MODEL)),
        "g_final": gain(ks[3], (D_MODEL,)),
        "gla_w_in": nrm(ks[4], (N_GLA, D_MODEL, GLA_IN_COLS), D_MODEL),
        "gla_w_a2": nrm(ks[5], (N_GLA, GLA_GATE_RANK, GLA_DK_TOT), GLA_GATE_RANK),
        "gla_b_a": 0.1 * jax.random.normal(ks[6], (N_GLA, GLA_DK_TOT), f32),
        "gla_g_out": gain(ks[7], (N_GLA, GLA_DV)),
        "gla_w_o": nrm(ks[8], (N_GLA, GLA_DV_TOT, D_MODEL), GLA_DV_TOT),
        "dsa_w_in": nrm(ks[9], (N_DSA, D_MODEL, DSA_IN_COLS), D_MODEL),
        "dsa_g_q": gain(ks[10], (N_DSA, DSA_Q_RANK)),
        "dsa_g_kv": gain(ks[11], (N_DSA, DSA_KV_RANK)),
        "dsa_w_q_up": nrm(ks[12], (N_DSA, DSA_Q_RANK, DSA_QUP_COLS), DSA_Q_RANK),
        "dsa_w_uk": nrm(ks[13], (N_DSA, DSA_HEADS, DSA_QK_DIM, DSA_KV_RANK), DSA_KV_RANK),
        "dsa_w_uv": nrm(ks[14], (N_DSA, DSA_HEADS, DSA_KV_RANK, DSA_V_DIM), DSA_KV_RANK),
        "dsa_w_o": nrm(ks[15], (N_DSA, DSA_HEADS * DSA_V_DIM, D_MODEL), DSA_HEADS * DSA_V_DIM),
        "ffn_w_up": nrm(ks[16], (DEPTH, D_MODEL, 2 * D_FF), D_MODEL),
        "ffn_conv_w": nrm(ks[17], (DEPTH, CONV_WIDTH, 2 * D_FF), CONV_WIDTH),
        "ffn_conv_b": 0.02 * jax.random.normal(ks[18], (DEPTH, 2 * D_FF), f32),
        "ffn_w_down": nrm(ks[19], (DEPTH, D_FF, D_MODEL), D_FF),
    }


def reference(x, g_mix, g_ffn, g_final, gla_w_in, gla_w_a2, gla_b_a, gla_g_out, gla_w_o,
              dsa_w_in, dsa_g_q, dsa_g_kv, dsa_w_q_up, dsa_w_uk, dsa_w_uv, dsa_w_o,
              ffn_w_up, ffn_conv_w, ffn_conv_b, ffn_w_down):
    h = x
    for i in range(DEPTH):
        j = i // N_MIXERS
        hn = rms_norm(h, g_mix[i])
        if i % N_MIXERS == 0:
            h = h + gla_mixer(hn, gla_w_in[j], gla_w_a2[j], gla_b_a[j], gla_g_out[j], gla_w_o[j])
        else:
            h = h + dsa_mixer(hn, dsa_w_in[j], dsa_g_q[j], dsa_g_kv[j], dsa_w_q_up[j],
                              dsa_w_uk[j], dsa_w_uv[j], dsa_w_o[j])
        h = h + conv_ffn(rms_norm(h, g_ffn[i]), ffn_w_up[i], ffn_conv_w[i], ffn_conv_b[i], ffn_w_down[i])
    return rms_norm(h, g_final)
```

```cpp
#include <hip/hip_runtime.h>
#include <stdint.h>
#include <stdio.h>

#define GAS __attribute__((address_space(1)))
#define LAS __attribute__((address_space(3)))
typedef unsigned short bf16_t;
typedef short bf16x8 __attribute__((ext_vector_type(8)));
typedef short s16x4 __attribute__((ext_vector_type(4)));
typedef float f32x4 __attribute__((ext_vector_type(4)));
typedef unsigned u32x4 __attribute__((ext_vector_type(4)));
typedef unsigned u32x2 __attribute__((ext_vector_type(2)));

namespace pg8 {
#define PG8_LAS __attribute__((address_space(3)))
typedef unsigned short bf16_t;
typedef short bf16x8 __attribute__((ext_vector_type(8)));
typedef float f32x4 __attribute__((ext_vector_type(4)));
typedef unsigned u32x4 __attribute__((ext_vector_type(4)));
constexpr int BM = 256, BK = 64, HALF = 128, HTB = HALF * BK * 2  , STAGE_BYTES = 8 * HTB, NXCD = 8, WGM = 8;

__host__ __device__ __forceinline__ int lds_byte(int r, int c) { const int st = (r >> 4) * 2 + (c >> 5), rr = r & 15, cc = c & 31, ob = rr * 64 + cc * 2; return st * 1024 + (ob ^ (((ob >> 9) & 1) << 5)); }
__host__ __device__ __forceinline__ void stage_rc(int b, int& R, int& C) { const int st = b / 1024, sb = b % 1024, swz = sb ^ (((sb >> 9) & 1) << 5); R = (st >> 1) * 16 + swz / 64; C = (st & 1) * 32 + (swz % 64) / 2; }
__host__ __device__ __forceinline__ int perm32(int rho) { const int n = rho >> 4, i = rho & 15; return 8 * (i >> 2) + 4 * n + (i & 3); }

struct Unit { int pm, pn; };
typedef int v4i_t __attribute__((ext_vector_type(4))); typedef int v8i_t __attribute__((ext_vector_type(8)));
struct Gemm { const bf16_t* A; const bf16_t* Bt; int M, N, K; int lda; };

struct StaticOrder {
    int nM, nN, nwg, G, c;
    __host__ __device__ void init(int M, int N, int G_, int c_) { nM = M / BM; nN = N / BM; nwg = nM * nN; G = G_; c = c_; }
    __host__ __device__ bool next(int i, Unit& u) const {
        const long L = (long)i * G + c; if (L >= nwg) return false;
        int wgid = (int)L; { const int q = nwg / NXCD, r = nwg % NXCD, xcd = wgid % NXCD, off = wgid / NXCD; wgid = (xcd < r ? xcd * (q + 1) : r * (q + 1) + (xcd - r) * q) + off; }
        const int nig = WGM * nN, gid = wgid / nig, fm = gid * WGM, gsz = (nM - fm) < WGM ? (nM - fm) : WGM;
        u.pm = fm + ((wgid % nig) % gsz); u.pn = (wgid % nig) / gsz; return true;
    }
    __device__ __forceinline__ void a_ready(const Unit&) const {}
    __device__ __forceinline__ void done(const Unit&) const {}
};
__device__ __forceinline__ unsigned cvt_pk_bf16(float lo, float hi) { unsigned r; asm volatile("v_cvt_pk_bf16_f32 %0, %1, %2" : "=v"(r) : "v"(lo), "v"(hi)); return r; }

struct EpiBf16Split {
    static constexpr bool PERM = true, AFTER_DRAIN = false, LDS_PRE = false;
    bf16_t* O; int ldc; int split_cols; size_t split_stride;
    __device__ __forceinline__ void operator()(const f32x4 (&acc)[2][2][4][2], const Unit& u, int wr, int wc, int fr, int fq) const {
        const int row0 = u.pm * BM + wr * 64 + fr; int colt = u.pn * BM; bf16_t* base = O;
        if (split_cols) { const int t = colt / split_cols; base += (size_t)t * split_stride; colt -= t * split_cols; }
        const int col0 = colt + wc * 32 + 8 * fq;
#pragma unroll
        for (int ai = 0; ai < 2; ++ai)
#pragma unroll
            for (int m = 0; m < 4; ++m) { bf16_t* rowp = base + (size_t)(row0 + ai * HALF + m * 16) * ldc + col0;
#pragma unroll
                for (int bj = 0; bj < 2; ++bj) { const f32x4 v0 = acc[ai][bj][m][0], v1 = acc[ai][bj][m][1];
                    u32x4 w; w.x = cvt_pk_bf16(v0[0], v0[1]); w.y = cvt_pk_bf16(v0[2], v0[3]); w.z = cvt_pk_bf16(v1[0], v1[1]); w.w = cvt_pk_bf16(v1[2], v1[3]);
                    *(u32x4*)(rowp + bj * HALF) = w; } }
    }
};
struct EpiF32 {
    static constexpr bool PERM = false, AFTER_DRAIN = false, LDS_PRE = false;
    float* C; int ldc;
    __device__ __forceinline__ void operator()(const f32x4 (&acc)[2][2][4][2], const Unit& u, int wr, int wc, int fr, int fq) const {
        const int row0 = u.pm * BM + wr * 64 + fr, col0 = u.pn * BM + wc * 32 + 4 * fq;
#pragma unroll
        for (int ai = 0; ai < 2; ++ai)
#pragma unroll
            for (int m = 0; m < 4; ++m) { float* rowp = C + (size_t)(row0 + ai * HALF + m * 16) * ldc + col0;
#pragma unroll
                for (int bj = 0; bj < 2; ++bj)
#pragma unroll
                    for (int n = 0; n < 2; ++n) *(f32x4*)(rowp + bj * HALF + n * 16) = acc[ai][bj][m][n]; }
    }
};
struct EpiResF32 {
    static constexpr bool PERM = false, AFTER_DRAIN = false, LDS_PRE = false;
    const float* R; float* C; int ldc;
    __device__ __forceinline__ void operator()(const f32x4 (&acc)[2][2][4][2], const Unit& u, int wr, int wc, int fr, int fq) const {
        const int row0 = u.pm * BM + wr * 64 + fr, col0 = u.pn * BM + wc * 32 + 4 * fq;
#pragma unroll
        for (int ai = 0; ai < 2; ++ai)
#pragma unroll
            for (int m = 0; m < 4; ++m) { const size_t off = (size_t)(row0 + ai * HALF + m * 16) * ldc + col0;
                f32x4 rv[2][2];
#pragma unroll
                for (int bj = 0; bj < 2; ++bj)
#pragma unroll
                    for (int n = 0; n < 2; ++n) rv[bj][n] = *(const f32x4*)(R + off + bj * HALF + n * 16);
#pragma unroll
                for (int bj = 0; bj < 2; ++bj)
#pragma unroll
                    for (int n = 0; n < 2; ++n) *(f32x4*)(C + off + bj * HALF + n * 16) = rv[bj][n] + acc[ai][bj][m][n];
                if (m & 1) asm volatile("" ::: "memory"); }
    }
};
template <bool RF32, int SH = 0> struct EpiResBf16 {
    static constexpr bool PERM = true, AFTER_DRAIN = false, LDS_PRE = false;
    const void* R; bf16_t* HB; int ldc;
    __device__ __forceinline__ void operator()(const f32x4 (&acc)[2][2][4][2], const Unit& u, int wr, int wc, int fr, int fq) const {
        const int row0 = u.pm * BM + wr * 64 + fr, col0 = u.pn * BM + wc * 32 + 8 * fq;
        if constexpr (!RF32) {
            u32x4 rw[2][4][2];
#pragma unroll
            for (int ai = 0; ai < 2; ++ai)
#pragma unroll
                for (int m = 0; m < 4; ++m)
#pragma unroll
                    for (int bj = 0; bj < 2; ++bj) rw[ai][m][bj] = *(const u32x4*)((const bf16_t*)R + (size_t)(row0 + ai * HALF + m * 16) * ldc + col0 + bj * HALF);
            asm volatile("" ::: "memory");
#pragma unroll
            for (int ai = 0; ai < 2; ++ai)
#pragma unroll
                for (int m = 0; m < 4; ++m) { const size_t off = (size_t)(row0 + ai * HALF + m * 16) * ldc + col0;
#pragma unroll
                    for (int bj = 0; bj < 2; ++bj) { const u32x4 w0 = rw[ai][m][bj]; constexpr float sc = 1.0f / (float)(1 << SH);
                        const f32x4 r0 = (f32x4){__builtin_bit_cast(float, w0.x << 16), __builtin_bit_cast(float, w0.x & 0xffff0000u), __builtin_bit_cast(float, w0.y << 16), __builtin_bit_cast(float, w0.y & 0xffff0000u)};
                        const f32x4 r1 = (f32x4){__builtin_bit_cast(float, w0.z << 16), __builtin_bit_cast(float, w0.z & 0xffff0000u), __builtin_bit_cast(float, w0.w << 16), __builtin_bit_cast(float, w0.w & 0xffff0000u)};
                        const f32x4 v0 = SH ? r0 + acc[ai][bj][m][0] * sc : r0 + acc[ai][bj][m][0], v1 = SH ? r1 + acc[ai][bj][m][1] * sc : r1 + acc[ai][bj][m][1];
                        u32x4 w; w.x = cvt_pk_bf16(v0[0], v0[1]); w.y = cvt_pk_bf16(v0[2], v0[3]); w.z = cvt_pk_bf16(v1[0], v1[1]); w.w = cvt_pk_bf16(v1[2], v1[3]);
                        *(u32x4*)(HB + off + bj * HALF) = w; } }
        } else {
#pragma unroll
        for (int ai = 0; ai < 2; ++ai)
#pragma unroll
            for (int m = 0; m < 4; ++m) { const size_t off = (size_t)(row0 + ai * HALF + m * 16) * ldc + col0;
                f32x4 r0[2], r1[2];
#pragma unroll
                for (int bj = 0; bj < 2; ++bj) { r0[bj] = *(const f32x4*)((const float*)R + off + bj * HALF); r1[bj] = *(const f32x4*)((const float*)R + off + bj * HALF + 4); }
#pragma unroll
                for (int bj = 0; bj < 2; ++bj) { constexpr float sc = 1.0f / (float)(1 << SH); const f32x4 v0 = SH ? r0[bj] + acc[ai][bj][m][0] * sc : r0[bj] + acc[ai][bj][m][0], v1 = SH ? r1[bj] + acc[ai][bj][m][1] * sc : r1[bj] + acc[ai][bj][m][1];
                    u32x4 w; w.x = cvt_pk_bf16(v0[0], v0[1]); w.y = cvt_pk_bf16(v0[2], v0[3]); w.z = cvt_pk_bf16(v1[0], v1[1]); w.w = cvt_pk_bf16(v1[2], v1[3]);
                    *(u32x4*)(HB + off + bj * HALF) = w; }
                if (m & 1) asm volatile("" ::: "memory"); }
        }
    }
};
struct EpiGlaIn {
    static constexpr bool PERM = true, AFTER_DRAIN = false, LDS_PRE = false;
    bf16_t *Q, *K, *V, *Rg; float* A1;
    __device__ __forceinline__ void operator()(const f32x4 (&acc)[2][2][4][2], const Unit& u, int wr, int wc, int fr, int fq) const {
        const int row0 = u.pm * BM + wr * 64 + fr; const int colt = u.pn * BM;
        if (u.pn < 48) {
            bf16_t* base; int ldc, c0;
            if (colt < 2048) { base = Q; ldc = 2048; c0 = colt; }
            else if (colt < 4096) { base = K; ldc = 2048; c0 = colt - 2048; }
            else if (colt < 8192) { base = V; ldc = 4096; c0 = colt - 4096; }
            else { base = Rg; ldc = 4096; c0 = colt - 8192; }
            const int col0 = c0 + wc * 32 + 8 * fq;
#pragma unroll
            for (int ai = 0; ai < 2; ++ai)
#pragma unroll
                for (int m = 0; m < 4; ++m) { bf16_t* rowp = base + (size_t)(row0 + ai * HALF + m * 16) * ldc + col0;
#pragma unroll
                    for (int bj = 0; bj < 2; ++bj) { const f32x4 v0 = acc[ai][bj][m][0], v1 = acc[ai][bj][m][1];
                        u32x4 w; w.x = cvt_pk_bf16(v0[0], v0[1]); w.y = cvt_pk_bf16(v0[2], v0[3]); w.z = cvt_pk_bf16(v1[0], v1[1]); w.w = cvt_pk_bf16(v1[2], v1[3]);
                        *(u32x4*)(rowp + bj * HALF) = w; } }
        } else if (wc == 0 && fq < 2) {
#pragma unroll
            for (int ai = 0; ai < 2; ++ai)
#pragma unroll
                for (int m = 0; m < 4; ++m) { float* p = A1 + (size_t)(row0 + ai * HALF + m * 16) * 16 + 8 * fq;
                    *(f32x4*)p = acc[ai][0][m][0]; *(f32x4*)(p + 4) = acc[ai][0][m][1]; }
        }
    }
};

__device__ __forceinline__ unsigned pack4_fp8_e(float a, float b, float c2, float d) {
    a = __builtin_amdgcn_fmed3f(a, -448.f, 448.f); b = __builtin_amdgcn_fmed3f(b, -448.f, 448.f); c2 = __builtin_amdgcn_fmed3f(c2, -448.f, 448.f); d = __builtin_amdgcn_fmed3f(d, -448.f, 448.f);
    unsigned p; asm volatile("v_cvt_pk_fp8_f32 %0, %1, %2" : "=v"(p) : "v"(a), "v"(b)); asm volatile("v_cvt_pk_fp8_f32 %0, %1, %2 op_sel:[0,0,1]" : "+v"(p) : "v"(c2), "v"(d)); return p; }
template <bool O8 = false> struct EpiDiag {
    static constexpr bool PERM = true, AFTER_DRAIN = false, LDS_PRE = false;
    bf16_t* O; int ldc; float osc;
    __device__ __forceinline__ void operator()(const f32x4 (&acc)[2][2][4][2], const Unit& u, int wr, int wc, int fr, int fq) const {
        const int row0 = u.pm * HALF + wr * 64 + fr, col0 = u.pn * BM + wc * 32 + 8 * fq;
#pragma unroll
        for (int ai = 0; ai < 2; ++ai)
#pragma unroll
            for (int m = 0; m < 4; ++m) { bf16_t* rowp = O + (size_t)(row0 + m * 16) * ldc + col0 + ai * HALF;
                const f32x4 v0 = acc[ai][ai][m][0], v1 = acc[ai][ai][m][1];
                if (O8) { u32x2 w; w.x = pack4_fp8_e(v0[0] * osc, v0[1] * osc, v0[2] * osc, v0[3] * osc); w.y = pack4_fp8_e(v1[0] * osc, v1[1] * osc, v1[2] * osc, v1[3] * osc);
                    *(u32x2*)((unsigned char*)O + (size_t)(row0 + m * 16) * ldc + col0 + ai * HALF) = w; }
                else { u32x4 w; w.x = cvt_pk_bf16(v0[0], v0[1]); w.y = cvt_pk_bf16(v0[2], v0[3]); w.z = cvt_pk_bf16(v1[0], v1[1]); w.w = cvt_pk_bf16(v1[2], v1[3]);
                    *(u32x4*)rowp = w; } }
    }
};

__device__ __forceinline__ float dpp_ror1f(float x) { return __builtin_bit_cast(float, __builtin_amdgcn_mov_dpp(__builtin_bit_cast(int, x), 0x121, 0xf, 0xf, false)); }
__device__ __forceinline__ float dpp_ror2f(float x) { return __builtin_bit_cast(float, __builtin_amdgcn_mov_dpp(__builtin_bit_cast(int, x), 0x122, 0xf, 0xf, false)); }
__device__ __forceinline__ f32x4 dpp_ror1(f32x4 v) { return (f32x4){dpp_ror1f(v.x), dpp_ror1f(v.y), dpp_ror1f(v.z), dpp_ror1f(v.w)}; }
__device__ __forceinline__ f32x4 dpp_ror2(f32x4 v) { return (f32x4){dpp_ror2f(v.x), dpp_ror2f(v.y), dpp_ror2f(v.z), dpp_ror2f(v.w)}; }
template <bool F8OUT = true, int ASH = 0> struct EpiConvAct {
    static constexpr bool PERM = true, AFTER_DRAIN = false, LDS_PRE = true;
    static constexpr int CONV_LDS = STAGE_BYTES;
    bf16_t* ACT; bf16_t* UH; const float* cw; const float* cb;
    __device__ __forceinline__ void prefetch(const Unit& u, PG8_LAS unsigned char* lds, int wid, int lane, int buf) const {
        constexpr int DFFc = 11008, DFF2c = 22016;
        const int arr = wid >> 1, isup = wid & 1;
        const float* src = (arr < 3 ? cw + (size_t)arr * DFF2c : cb) + (isup ? DFFc : 0) + u.pn * HALF;
        PG8_LAS unsigned char* dst = lds + CONV_LDS + buf * 4096 + wid * 512;
        __builtin_amdgcn_global_load_lds((const unsigned*)(src + lane), (PG8_LAS unsigned*)dst, 4, 0, 0);
        __builtin_amdgcn_global_load_lds((const unsigned*)(src + 64 + lane), (PG8_LAS unsigned*)(dst + 256), 4, 0, 0);
    }
    __device__ __forceinline__ void operator()(const f32x4 (&acc)[2][2][4][2], const Unit& u, int wr, int wc, int fr, int fq, const PG8_LAS unsigned char* lds, int buf) const {
        constexpr int DFFc = 11008, DFF2c = 22016;
        const PG8_LAS unsigned char* cl = lds + CONV_LDS + buf * 4096;
        const int lc = wc * 32 + 8 * fq, gc = u.pn * HALF + lc, run0 = u.pm * BM + wr * 64;
        unsigned pk[2][4][2];
#pragma unroll
        for (int n = 0; n < 2; ++n) {
            const int cg = gc + 4 * n, cu = DFFc + gc + 4 * n;
            const int lo4 = (lc + 4 * n) * 4; (void)cg; (void)cu;
#define PG8_CL(s) (*(const PG8_LAS f32x4*)(cl + (s) * 512 + lo4))
            constexpr float ASC = 1.0f / (float)(1 << ASH), CG = -1.4426950408889634f, CU = (F8OUT ? 4.0f : 1.0f) / CG, TG = CG * ASC, TU = CU * ASC;
            const f32x4 wg0 = PG8_CL(0) * TG, wg1 = PG8_CL(2) * TG, wg2 = PG8_CL(4) * TG, bg = PG8_CL(6) * CG;
            const f32x4 wu0 = PG8_CL(1) * TU, wu1 = PG8_CL(3) * TU, wu2 = PG8_CL(5) * TU, bu = PG8_CL(7) * CU;
#undef PG8_CL
#pragma unroll
            for (int ai = 0; ai < 2; ++ai) {
                f32x4 pg1 = (f32x4){0.f, 0.f, 0.f, 0.f}, pg2 = pg1, pu1 = pg1, pu2 = pg1;
                const int run = (run0 + ai * HALF) >> 6;
#pragma unroll
                for (int m = 0; m < 4; ++m) {
                    const f32x4 g = acc[ai][0][m][n], uu = acc[ai][1][m][n];
                    const f32x4 r1g = dpp_ror1(g), r2g = dpp_ror2(g), r1u = dpp_ror1(uu), r2u = dpp_ror2(uu);
                    const f32x4 s1g = fr == 0 ? pg1 : r1g, s2g = fr < 2 ? pg2 : r2g, s1u = fr == 0 ? pu1 : r1u, s2u = fr < 2 ? pu2 : r2u;
                    const f32x4 yg = bg + wg0 * s2g + wg1 * s1g + wg2 * g, yu = bu + wu0 * s2u + wu1 * s1u + wu2 * uu;
                    float a[4];
#pragma unroll
                    for (int i = 0; i < 4; ++i) a[i] = yg[i] * __builtin_amdgcn_rcpf(1.0f + __builtin_amdgcn_exp2f(yg[i])) * yu[i];
                    if constexpr (F8OUT) {
                        const unsigned q8 = pack4_fp8_e(a[0], a[1], a[2], a[3]);
                        if (n == 0) pk[ai][m][0] = q8;
                        else if (m > 0 || fr >= 2) { u32x2 w; w.x = pk[ai][m][0]; w.y = q8; *(u32x2*)((unsigned char*)ACT + (size_t)(run0 + ai * HALF + m * 16 + fr) * DFFc + gc) = w; }
                    } else {
                        const unsigned lo = cvt_pk_bf16(a[0], a[1]), hi = cvt_pk_bf16(a[2], a[3]);
                        if (n == 0) { pk[ai][m][0] = lo; pk[ai][m][1] = hi; }
                        else if (m > 0 || fr >= 2) { u32x4 w; w.x = pk[ai][m][0]; w.y = pk[ai][m][1]; w.z = lo; w.w = hi; *(u32x4*)(ACT + (size_t)(run0 + ai * HALF + m * 16 + fr) * DFFc + gc) = w; }
                    }
                    if ((m == 0 && fr < 2) || (m == 3 && fr >= 14)) {
                        const int slot = m == 0 ? 2 + fr : fr - 14;
                        bf16_t* hp = UH + ((size_t)run * 4 + slot) * DFF2c + u.pn * BM + lc + 4 * n;
                        const f32x4 gs = ASH ? g * ASC : g, us = ASH ? uu * ASC : uu;
                        u32x2 hg, hu; hg.x = cvt_pk_bf16(gs[0], gs[1]); hg.y = cvt_pk_bf16(gs[2], gs[3]); hu.x = cvt_pk_bf16(us[0], us[1]); hu.y = cvt_pk_bf16(us[2], us[3]);
                        *(u32x2*)hp = hg; *(u32x2*)(hp + HALF) = hu; }
                    pg1 = r1g; pg2 = r2g; pu1 = r1u; pu2 = r2u;
                }
            }
        }
    }
};

template <class Epi, class Sched, bool ALIGN_EPI = false, bool SP2 = false, int MODE = 0, bool F8 = false>
__device__ __forceinline__ void gemm_phase(PG8_LAS unsigned char* lds, const Gemm g, const Sched& S, const Epi& E, const int tid_in) {
    const int tid = tid_in, wid = __builtin_amdgcn_readfirstlane(tid >> 6), lane = tid & 63, wr = wid >> 2, wc = wid & 3, fr = lane & 15, fq = lane >> 4;
    const int K = g.K, nt = K / BK;
    const int lda = MODE ? g.lda : K;
    unsigned voffA[2], voffB[2];
#pragma unroll
    for (int i = 0; i < 2; ++i) { int R, C; stage_rc(tid * 16 + i * 8192, R, C); const int Rb = Epi::PERM ? ((R & ~31) + perm32(R & 31)) : R;
        voffA[i] = (unsigned)(R * lda + C) * 2u; voffB[i] = (unsigned)(Rb * K + C) * 2u; }
    const size_t kstep = (size_t)(BK * 2);
    const size_t hstepB = (size_t)HALF * K * 2, tstepB = 2 * hstepB;
    const size_t hstepA = (MODE == 2) ? (size_t)(F8 ? 512 : 1024) : (size_t)HALF * lda * 2;
    const size_t tstepA = (MODE == 2) ? (size_t)HALF * lda * 2 : 2 * (size_t)HALF * lda * 2;
#define PG8_APTR(u) ((const char*)g.A + (size_t)(u).pm * tstepA + (MODE == 1 ? (size_t)((u).pn >> 1) * 256 : (MODE == 2 ? (size_t)(u).pn * (F8 ? 1024 : 2048) : (size_t)0)))
#define PG8_BPTR(u) ((const char*)g.Bt + (size_t)(u).pn * tstepB)
#define PG8_MMAX(ai, bj, At, Bt) do { if constexpr (MODE != 2) PG8_MMA(ai, bj, At, Bt); } while (0)
    const unsigned ldsw = (unsigned)wid * 1024u;
    const int aoff = lds_byte(wr * 64 + fr, fq * 8), boff = lds_byte(wc * 32 + fr, fq * 8);
#define PG8_SA(b, h) (((b) * 2 + (h)) * HTB)
#define PG8_SB(b, h) ((4 + (b) * 2 + (h)) * HTB)
#define PG8_STAGE(bufoff, gbase, voff) do { _Pragma("unroll") for (int _i = 0; _i < 2; ++_i) \
        __builtin_amdgcn_global_load_lds((const unsigned*)((const char*)(gbase) + (voff)[_i]), (PG8_LAS unsigned*)(lds + (bufoff) + ldsw + _i * 8192), 16, 0, 0); } while (0)
#define PG8_LDA(dst, b, h) do { _Pragma("unroll") for (int m = 0; m < 4; ++m) _Pragma("unroll") for (int k = 0; k < 2; ++k) dst[m][k] = *(const PG8_LAS bf16x8*)(lds + PG8_SA(b, h) + aoff + m * 2048 + k * 1024); } while (0)
#define PG8_LDB(dst, b, h) do { _Pragma("unroll") for (int n = 0; n < 2; ++n) _Pragma("unroll") for (int k = 0; k < 2; ++k) dst[n][k] = *(const PG8_LAS bf16x8*)(lds + PG8_SB(b, h) + boff + n * 2048 + k * 1024); } while (0)
#define PG8_MMA(ai, bj, At, Bt) do { __builtin_amdgcn_s_setprio(1); \
        if constexpr (F8) { _Pragma("unroll") for (int m = 0; m < 4; ++m) _Pragma("unroll") for (int n = 0; n < 2; ++n) { \
            const v8i_t b8 = __builtin_shufflevector(__builtin_bit_cast(v4i_t, Bt[n][0]), __builtin_bit_cast(v4i_t, Bt[n][1]), 0, 1, 2, 3, 4, 5, 6, 7); \
            const v8i_t a8 = __builtin_shufflevector(__builtin_bit_cast(v4i_t, At[m][0]), __builtin_bit_cast(v4i_t, At[m][1]), 0, 1, 2, 3, 4, 5, 6, 7); \
            asm("v_mfma_f32_16x16x128_f8f6f4 %0, %1, %2, %0" : "+v"(acc[ai][bj][m][n]) : "v"(b8), "v"(a8)); } } \
        else { _Pragma("unroll") for (int m = 0; m < 4; ++m) _Pragma("unroll") for (int n = 0; n < 2; ++n) _Pragma("unroll") for (int k = 0; k < 2; ++k) \
            acc[ai][bj][m][n] = __builtin_amdgcn_mfma_f32_16x16x32_bf16(Bt[n][k], At[m][k], acc[ai][bj][m][n], 0, 0, 0); } \
        __builtin_amdgcn_s_setprio(0); } while (0)
#define PG8_WAIT_V(n) asm volatile("s_waitcnt vmcnt(" #n ")" ::: "memory")
#define PG8_WAIT_L(n) asm volatile("s_waitcnt lgkmcnt(" #n ")" ::: "memory")
#define PG8_BAR __builtin_amdgcn_s_barrier()
#define PG8_SCHED __builtin_amdgcn_sched_barrier(0)
    Unit cur, nxt; int ui = 0;
    if (!S.next(0, cur)) return;
    f32x4 acc[2][2][4][2];
#pragma unroll
    for (int a = 0; a < 2; ++a)
#pragma unroll
        for (int b = 0; b < 2; ++b)
#pragma unroll
            for (int m = 0; m < 4; ++m)
#pragma unroll
                for (int n = 0; n < 2; ++n) acc[a][b][m][n] = (f32x4){0.f, 0.f, 0.f, 0.f};
    bf16x8 At[4][2], B0[2][2], B1[2][2];
    const char* cA = PG8_APTR(cur); const char* cB = PG8_BPTR(cur);
    S.a_ready(cur);
    if constexpr (Epi::LDS_PRE) E.prefetch(cur, lds, wid, lane, 0);
    if constexpr (SP2) {
        PG8_STAGE(PG8_SB(0, 0), cB, voffB); PG8_STAGE(PG8_SB(0, 1), cB + hstepB, voffB); PG8_STAGE(PG8_SA(0, 0), cA, voffA); PG8_STAGE(PG8_SA(0, 1), cA + hstepA, voffA);
        if (wr == 1) PG8_BAR;
        PG8_WAIT_V(2); PG8_BAR;
        PG8_STAGE(PG8_SB(1, 0), cB + kstep, voffB); PG8_STAGE(PG8_SA(1, 0), cA + kstep, voffA); PG8_STAGE(PG8_SB(1, 1), cB + hstepB + kstep, voffB);
        PG8_WAIT_V(6); PG8_BAR;
    } else {
        PG8_STAGE(PG8_SB(0, 0), cB, voffB); PG8_STAGE(PG8_SA(0, 0), cA, voffA); PG8_STAGE(PG8_SB(0, 1), cB + hstepB, voffB); PG8_STAGE(PG8_SA(0, 1), cA + hstepA, voffA);
        if (wr == 1) PG8_BAR;
        PG8_WAIT_V(4); PG8_BAR;
        PG8_STAGE(PG8_SB(1, 0), cB + kstep, voffB); PG8_STAGE(PG8_SA(1, 0), cA + kstep, voffA); PG8_STAGE(PG8_SB(1, 1), cB + hstepB + kstep, voffB);
        PG8_WAIT_V(6); PG8_BAR;
    }
    for (;;) {
        const bool has_next = S.next(ui + 1, nxt);
        const char* nA = has_next ? PG8_APTR(nxt) : cA; const char* nB = has_next ? PG8_BPTR(nxt) : cB;
        for (int t = 0; t < nt; t += 2) {
            const bool last = (t == nt - 2);
            const char* a1 = cA + (size_t)(t + 1) * kstep;
            const char* a2 = last ? nA : cA + (size_t)(t + 2) * kstep; const char* b2 = last ? nB : cB + (size_t)(t + 2) * kstep;
            const char* a3 = a2 + kstep; const char* b3 = b2 + kstep;
            if (last && has_next) S.a_ready(nxt);
            if constexpr (SP2) {
            PG8_LDB(B0, 0, 0); PG8_LDB(B1, 0, 1); PG8_SCHED; PG8_LDA(At, 0, 0); PG8_STAGE(PG8_SA(1, 1), a1 + hstepA, voffA);
            PG8_WAIT_V(8); PG8_WAIT_L(0); PG8_BAR; PG8_MMA(0, 0, At, B0); PG8_MMAX(0, 1, At, B1); PG8_BAR; PG8_SCHED;
            PG8_LDA(At, 0, 1); PG8_STAGE(PG8_SB(0, 0), b2, voffB); PG8_STAGE(PG8_SB(0, 1), b2 + hstepB, voffB); PG8_STAGE(PG8_SA(0, 0), a2, voffA);
            PG8_WAIT_V(8); PG8_WAIT_L(0); PG8_BAR; PG8_MMAX(1, 0, At, B0); PG8_MMA(1, 1, At, B1); PG8_BAR; PG8_SCHED;
            PG8_LDB(B0, 1, 0); PG8_LDB(B1, 1, 1); PG8_SCHED; PG8_LDA(At, 1, 0); PG8_STAGE(PG8_SA(0, 1), a2 + hstepA, voffA);
            PG8_WAIT_V(8); PG8_WAIT_L(0); PG8_BAR; PG8_MMA(0, 0, At, B0); PG8_MMAX(0, 1, At, B1); PG8_BAR; PG8_SCHED;
            PG8_LDA(At, 1, 1); PG8_STAGE(PG8_SB(1, 0), b3, voffB); PG8_STAGE(PG8_SB(1, 1), b3 + hstepB, voffB); PG8_STAGE(PG8_SA(1, 0), a3, voffA);
            PG8_WAIT_V(8); PG8_WAIT_L(0); PG8_BAR; PG8_MMAX(1, 0, At, B0); PG8_MMA(1, 1, At, B1); PG8_BAR; PG8_SCHED;
            } else {
            PG8_LDB(B0, 0, 0); PG8_SCHED; PG8_LDA(At, 0, 0); PG8_STAGE(PG8_SA(1, 1), a1 + hstepA, voffA);
            PG8_WAIT_L(8); PG8_BAR; PG8_WAIT_L(0); PG8_MMA(0, 0, At, B0); PG8_BAR; PG8_SCHED;
            PG8_LDB(B1, 0, 1); PG8_STAGE(PG8_SB(0, 0), b2, voffB);
            PG8_BAR; PG8_WAIT_L(0); PG8_MMAX(0, 1, At, B1); PG8_BAR;
            PG8_LDA(At, 0, 1); PG8_STAGE(PG8_SA(0, 0), a2, voffA);
            PG8_BAR; PG8_WAIT_L(0); PG8_MMAX(1, 0, At, B0); PG8_BAR; PG8_SCHED;
            PG8_STAGE(PG8_SB(0, 1), b2 + hstepB, voffB);
            PG8_WAIT_V(6); PG8_BAR; PG8_MMA(1, 1, At, B1); PG8_BAR;
            PG8_LDB(B0, 1, 0); PG8_SCHED; PG8_LDA(At, 1, 0); PG8_STAGE(PG8_SA(0, 1), a2 + hstepA, voffA);
            PG8_WAIT_L(8); PG8_BAR; PG8_WAIT_L(0); PG8_MMA(0, 0, At, B0); PG8_BAR; PG8_SCHED;
            PG8_LDB(B1, 1, 1); PG8_STAGE(PG8_SB(1, 0), b3, voffB);
            PG8_BAR; PG8_WAIT_L(0); PG8_MMAX(0, 1, At, B1); PG8_BAR;
            PG8_LDA(At, 1, 1); PG8_STAGE(PG8_SA(1, 0), a3, voffA);
            PG8_BAR; PG8_WAIT_L(0); PG8_MMAX(1, 0, At, B0); PG8_BAR; PG8_SCHED;
            PG8_STAGE(PG8_SB(1, 1), b3 + hstepB, voffB);
            PG8_WAIT_V(6); PG8_BAR; PG8_MMA(1, 1, At, B1); PG8_BAR;
            }
        }
        if constexpr (F8) asm volatile("s_nop 15\n\ts_nop 15" ::: "memory");
        if constexpr (ALIGN_EPI) { if (wr == 0) PG8_BAR; }
        if constexpr (Epi::LDS_PRE) { if (has_next) E.prefetch(nxt, lds, wid, lane, (ui + 1) & 1); E(acc, cur, wr, wc, fr, fq, lds, ui & 1); S.done(cur); }
        else if constexpr (!Epi::AFTER_DRAIN) { E(acc, cur, wr, wc, fr, fq); S.done(cur); }
        if (!has_next) break;
#pragma unroll
        for (int a = 0; a < 2; ++a)
#pragma unroll
            for (int b = 0; b < 2; ++b)
#pragma unroll
                for (int m = 0; m < 4; ++m)
#pragma unroll
                    for (int n = 0; n < 2; ++n) acc[a][b][m][n] = (f32x4){0.f, 0.f, 0.f, 0.f};
        cur = nxt; cA = nA; cB = nB; ++ui;
        if constexpr (ALIGN_EPI) { if (wr == 1) PG8_BAR; }
    }
    PG8_WAIT_V(0);
    if constexpr (!ALIGN_EPI) { if (wr == 0) PG8_BAR; }
    PG8_BAR;
    if constexpr (Epi::AFTER_DRAIN) { E.fused(acc, cur, wr, wc, fr, fq, lds, wid, lane); S.done(cur); }
#undef PG8_SA
#undef PG8_APTR
#undef PG8_BPTR
#undef PG8_MMAX
#undef PG8_SB
#undef PG8_STAGE
#undef PG8_LDA
#undef PG8_LDB
#undef PG8_MMA
#undef PG8_WAIT_V
#undef PG8_WAIT_L
#undef PG8_BAR
#undef PG8_SCHED
}
}

constexpr int NWAVES = 8, NTHR = NWAVES * 64;
constexpr int D = 4096, SEQ = 8192, M = 2 * SEQ;
constexpr int GLA_IN_N = 12304, GLA_IN_NP = 12544;
constexpr int DSA_IN_N = 1728, DSA_IN_NP = 1792;
constexpr int DFF = 11008, DFF2 = 22016;
constexpr float RMS_EPS = 1e-6f;
constexpr float ACT_SC = 4.0f, WDN_SC = 128.0f; constexpr int DN_SH = 9;
constexpr float HN8_SC = 16.0f, WUP_SC = 128.0f; constexpr int UP_SH = 11;
constexpr float DSO_SC = 32.0f, WO_SC = 128.0f; constexpr int DSAO_SH = 12;
constexpr float OL_SC = 64.0f, WUV_SC = 128.0f;

constexpr size_t MiB = 1u << 20;
constexpr size_t WS_CTL = 0, CTL_ZERO_BYTES = 64 * 1024;
constexpr size_t WS_W_GLA_IN = 1 * MiB;
constexpr size_t WS_W_GLA_O  = WS_W_GLA_IN + 98 * MiB;
constexpr size_t WS_W_DSA_IN = WS_W_GLA_O + 32 * MiB;
constexpr size_t WS_W_QUP    = WS_W_DSA_IN + 14 * MiB;
constexpr size_t WS_W_UK     = WS_W_QUP + 32 * MiB;
constexpr size_t WS_W_UV     = WS_W_UK + 8 * MiB;
constexpr size_t WS_W_DSA_O  = WS_W_UV + 8 * MiB;
constexpr size_t WS_W_UP     = WS_W_DSA_O + 64 * MiB;
constexpr size_t WS_W_DN     = WS_W_UP + 344 * MiB;
constexpr size_t WS_H        = WS_W_DN + 172 * MiB;
constexpr size_t WS_HN       = WS_H + 256 * MiB;
constexpr size_t WS_BIG      = WS_HN + 128 * MiB;
constexpr size_t WS_GQ   = WS_BIG;
constexpr size_t WS_GK   = WS_GQ + 64 * MiB;
constexpr size_t WS_GV   = WS_GK + 64 * MiB;
constexpr size_t WS_GR   = WS_GV + 128 * MiB;
constexpr size_t WS_GA1  = WS_GR + 128 * MiB;
constexpr size_t WS_GKT  = WS_GA1 + 1 * MiB;
constexpr size_t WS_GEBL = WS_GKT + 64 * MiB;
constexpr size_t WS_GORAW = WS_GEBL + 2 * MiB;
constexpr size_t WS_GOG  = WS_GORAW + 256 * MiB;
constexpr size_t WS_GLA_END = WS_GOG + 128 * MiB;
constexpr size_t WS_U    = WS_BIG;
constexpr size_t WS_ACT  = WS_U + 688 * MiB;
constexpr size_t WS_FFN_END = WS_ACT + 344 * MiB;
constexpr size_t WS_CKV  = WS_BIG;
constexpr size_t WS_KIDX = WS_CKV + 16 * MiB;
constexpr size_t WS_WIDX = WS_KIDX + 4 * MiB;
constexpr size_t WS_SEL  = WS_WIDX + 4 * MiB;
constexpr size_t WS_CQN  = WS_SEL + 16 * MiB;
constexpr size_t WS_QATT = WS_CQN + 32 * MiB;
constexpr size_t WS_X    = WS_QATT + 256 * MiB;
constexpr size_t WS_Z    = WS_X;
constexpr size_t WS_QIDX = WS_X + 128 * MiB;
constexpr size_t WS_SC   = WS_X + 384 * MiB;
constexpr size_t WS_QLAT = WS_X;
constexpr size_t WS_DSA_END = WS_X + 1024 * MiB;
constexpr size_t WS_END = WS_DSA_END > WS_FFN_END ? (WS_DSA_END > WS_GLA_END ? WS_DSA_END : WS_GLA_END) : (WS_FFN_END > WS_GLA_END ? WS_FFN_END : WS_GLA_END);
static_assert(WS_SC + 512 * MiB <= WS_DSA_END && WS_QIDX + 256 * MiB <= WS_SC && WS_Z + 112 * MiB <= WS_QIDX, "DSA map");
static_assert(WS_END <= (size_t)2752 * MiB, "workspace over the guaranteed size");

constexpr int CW_BAR = 4096;
constexpr int LDS_BYTES = 159744;
constexpr int MISC_OFF = 158720;

#define LDS_WAIT() asm volatile("s_waitcnt lgkmcnt(0)" ::: "memory")
#define VM_WAIT() asm volatile("s_waitcnt vmcnt(0)" ::: "memory")
__device__ __forceinline__ unsigned f2bf(float f) { unsigned u = __builtin_bit_cast(unsigned, f); return (u + 0x7fffu + ((u >> 16) & 1u)) >> 16; }
__device__ __forceinline__ unsigned pk2(float lo, float hi) { return f2bf(lo) | (f2bf(hi) << 16); }
__device__ __forceinline__ float bf2f(unsigned b) { return __builtin_bit_cast(float, b << 16); }
__device__ __forceinline__ float bflo(unsigned w) { return __builtin_bit_cast(float, w << 16); }
__device__ __forceinline__ float bfhi(unsigned w) { return __builtin_bit_cast(float, w & 0xffff0000u); }
__device__ __forceinline__ float wave_sum(float v) {
#pragma unroll
    for (int o = 1; o < 64; o <<= 1) v += __shfl_xor(v, o);
    return v;
}
__device__ __forceinline__ float wave_max(float v) {
#pragma unroll
    for (int o = 1; o < 64; o <<= 1) v = fmaxf(v, __shfl_xor(v, o));
    return v;
}
__device__ __forceinline__ float u2f(unsigned u) { return __builtin_bit_cast(float, u); }
__device__ __forceinline__ unsigned f2u(float f) { return __builtin_bit_cast(unsigned, f); }
__device__ __forceinline__ float xmax_rows(float x) {
    auto r = __builtin_amdgcn_permlane16_swap(f2u(x), f2u(x), false, false); const unsigned r0 = r[0], r1 = r[1]; const float m = fmaxf(u2f(r0), u2f(r1));
    auto q = __builtin_amdgcn_permlane32_swap(f2u(m), f2u(m), false, false); const unsigned q0 = q[0], q1 = q[1]; return fmaxf(u2f(q0), u2f(q1)); }
__device__ __forceinline__ float xsum_rows(float x) {
    auto r = __builtin_amdgcn_permlane16_swap(f2u(x), f2u(x), false, false); const unsigned r0 = r[0], r1 = r[1]; const float m = u2f(r0) + u2f(r1);
    auto q = __builtin_amdgcn_permlane32_swap(f2u(m), f2u(m), false, false); const unsigned q0 = q[0], q1 = q[1]; return u2f(q0) + u2f(q1); }
__device__ __forceinline__ float swapsum32(float a, float b) {
    auto r = __builtin_amdgcn_permlane32_swap(f2u(a), f2u(b), false, false); const unsigned r0 = r[0], r1 = r[1]; return u2f(r0) + u2f(r1); }
__device__ __forceinline__ float swapsum16(float a, float b) {
    auto r = __builtin_amdgcn_permlane16_swap(f2u(a), f2u(b), false, false); const unsigned r0 = r[0], r1 = r[1]; return u2f(r0) + u2f(r1); }
__device__ __forceinline__ int hw_lane() { unsigned ones = ~0u; asm volatile("" : "+s"(ones)); return (int)__builtin_amdgcn_mbcnt_hi(ones, __builtin_amdgcn_mbcnt_lo(ones, 0u)); }
__device__ __forceinline__ f32x4 mfma16(bf16x8 a, bf16x8 b, f32x4 c) { return __builtin_amdgcn_mfma_f32_16x16x32_bf16(a, b, c, 0, 0, 0); }
__device__ __forceinline__ bf16x8 lfrag(const LAS unsigned char* base, int row, int pitch, int col) { return *(const LAS bf16x8*)(base + row * pitch + col * 2); }

#define XB_TMO      128
#define XB_XCNT(j)  (256  + 64 * (j))
#define XB_XSUB(j)  (1280 + 64 * (j))
#define XB_XGEN(j)  (2304 + 64 * (j))
#define XB_TOP      3328
#define XB_TOPGEN   3392
#define XCD_BAR_WORDS 3456
#define XB_SPIN_CAP (1u << 18)

__device__ __forceinline__ unsigned xb_ld(unsigned* p)              { return __hip_atomic_load(p, __ATOMIC_RELAXED, __HIP_MEMORY_SCOPE_AGENT); }
__device__ __forceinline__ unsigned xb_add(unsigned* p, unsigned v) { return __hip_atomic_fetch_add(p, v, __ATOMIC_RELAXED, __HIP_MEMORY_SCOPE_AGENT); }
__device__ __forceinline__ unsigned xb_xcc_id() { return (unsigned)__builtin_amdgcn_s_getreg((3 << 11) | 20) & 0xFu; }
#define XB_SPIN(cond, bar) do { unsigned _sp = 0; while (cond) { __builtin_amdgcn_s_sleep(1); \
    if ((++_sp & 255u) == 0u) { if (xb_ld(&(bar)[XB_TMO])) break; if (_sp > XB_SPIN_CAP) { atomicAdd(&(bar)[XB_TMO], 1u); break; } } } } while (0)

struct XcdBarrier {
    unsigned* bar; unsigned x;
    volatile LAS unsigned* st;
};

__device__ __forceinline__ XcdBarrier xcd_barrier_post(unsigned* bar, volatile LAS unsigned* st) {
    XcdBarrier b; b.bar = bar; b.x = xb_xcc_id(); b.st = st;
    if (threadIdx.x == 0) (void)xb_add(&bar[XB_XCNT(b.x)], 1u);
    return b;
}
__device__ __forceinline__ void xcd_barrier_complete(unsigned* bar, unsigned x, unsigned& nloc, unsigned& nx) {
    const unsigned G = gridDim.x * gridDim.y * gridDim.z;
    unsigned sum, cnt, mine, sp = 0u;
    for (;;) {
        sum = 0u; cnt = 0u; mine = 0u;
#pragma unroll
        for (unsigned j = 0; j < 16; ++j) { const unsigned c = xb_ld(&bar[XB_XCNT(j)]); sum += c; cnt += (c > 0u) ? 1u : 0u; mine = (j == x) ? c : mine; }
        if (sum == G) break;
        __builtin_amdgcn_s_sleep(1);
        if ((++sp & 255u) == 0u) { if (xb_ld(&bar[XB_TMO])) break; if (sp > XB_SPIN_CAP) { atomicAdd(&bar[XB_TMO], 1u); break; } }
    }
    nloc = mine > 0u ? mine : 1u; nx = cnt > 0u ? cnt : 1u;
}

__device__ __forceinline__ void xcd_barrier(const XcdBarrier& b, const bool t0  ) {
    asm volatile("s_waitcnt vmcnt(0)" ::: "memory");
    __syncthreads();
    if (t0) {
        unsigned* bar = b.bar;
        __builtin_amdgcn_s_waitcnt(0);
        unsigned nloc = b.st[0], nx = b.st[1];
        if (nloc == 0u) { xcd_barrier_complete(bar, b.x, nloc, nx); b.st[0] = nloc; b.st[1] = nx; }
        const unsigned old = xb_add(&bar[XB_XSUB(b.x)], 1u);
        const unsigned gen = old / nloc;
        if (old + 1u == (gen + 1u) * nloc) {
            __builtin_amdgcn_fence(__ATOMIC_RELEASE, "agent");
            asm volatile("s_waitcnt vmcnt(0)" ::: "memory");
            const unsigned og = xb_add(&bar[XB_TOP], 1u);
            const unsigned tg = og / nx;
            if (og + 1u == (tg + 1u) * nx) xb_add(&bar[XB_TOPGEN], 1u);
            else XB_SPIN(xb_ld(&bar[XB_TOPGEN]) == tg, bar);
            __builtin_amdgcn_fence(__ATOMIC_ACQUIRE, "agent");
            xb_add(&bar[XB_XGEN(b.x)], 1u);
            asm volatile("s_waitcnt vmcnt(0)" ::: "memory");
        } else {
            XB_SPIN(xb_ld(&bar[XB_XGEN(b.x)]) == gen, bar);
            __builtin_amdgcn_fence(__ATOMIC_ACQUIRE, "agent");
            asm volatile("s_waitcnt vmcnt(0)" ::: "memory");
        }
    }
    __syncthreads();
}

__device__ __forceinline__ unsigned pack4_fp8(float a, float b, float c2, float d) {
    a = __builtin_amdgcn_fmed3f(a, -448.f, 448.f); b = __builtin_amdgcn_fmed3f(b, -448.f, 448.f); c2 = __builtin_amdgcn_fmed3f(c2, -448.f, 448.f); d = __builtin_amdgcn_fmed3f(d, -448.f, 448.f);
    int p = 0; p = __builtin_amdgcn_cvt_pk_fp8_f32(a, b, p, false); p = __builtin_amdgcn_cvt_pk_fp8_f32(c2, d, p, true); return (unsigned)p; }
template <bool ILV> struct TrItem { const float* W; bf16_t* WT; int k0, n0, d0; };
template <bool ILV, bool O8 = false> __device__ __forceinline__ TrItem<ILV> tr_decode(const float* W, int batch_per, int K, int N, int Npad, bf16_t* WT, int it) {
    const int bi = it / batch_per, item = it - bi * batch_per;
    const int nblk = Npad / 64, kb = item / nblk, nb = item - kb * nblk, n0 = 64 * nb;
    const int d0 = ILV ? (n0 < DFF ? 256 * (n0 >> 7) + (n0 & 127) : 256 * ((n0 - DFF) >> 7) + 128 + ((n0 - DFF) & 127)) : n0;
    return TrItem<ILV>{W + (size_t)bi * K * N, WT + (size_t)bi * Npad * K / (O8 ? 2 : 1), 64 * kb, n0, d0};
}
template <bool ILV> __device__ __forceinline__ void tr_load(f32x4 (&v)[16], const TrItem<ILV>& t, int N, int lane) {
    const int r4 = lane >> 4, c4 = lane & 15, nn = t.n0 + 4 * c4; const bool ok = nn < N;
#pragma unroll
    for (int i = 0; i < 16; ++i) v[i] = ok ? __builtin_nontemporal_load((const f32x4*)(t.W + (size_t)(t.k0 + 4 * i + r4) * N + nn)) : (f32x4){0.f, 0.f, 0.f, 0.f};
}
template <bool ILV, bool O8> __device__ __forceinline__ void tr_store(const f32x4 (&v)[16], const TrItem<ILV>& t, int K, LAS float* scr, int lane, float osc) {
    const int r4 = lane >> 4, c4 = lane & 15;
#pragma unroll
    for (int i = 0; i < 16; ++i) { LAS float* s = scr + (4 * i + r4) * 65 + 4 * c4; s[0] = v[i].x; s[1] = v[i].y; s[2] = v[i].z; s[3] = v[i].w; }
    LDS_WAIT(); asm volatile("" ::: "memory");
    const int c = lane & 7;
#pragma unroll
    for (int j = 0; j < 8; ++j) { const int n = (lane >> 3) + 8 * j; const LAS float* s = scr + (8 * c) * 65 + n;
        if (O8) { u32x2 o; o.x = pack4_fp8(s[0 * 65] * osc, s[1 * 65] * osc, s[2 * 65] * osc, s[3 * 65] * osc); o.y = pack4_fp8(s[4 * 65] * osc, s[5 * 65] * osc, s[6 * 65] * osc, s[7 * 65] * osc);
            *(u32x2*)((unsigned char*)t.WT + (size_t)(t.d0 + n) * K + t.k0 + 8 * c) = o; }
        else { u32x4 o; o.x = pk2(s[0 * 65], s[1 * 65]); o.y = pk2(s[2 * 65], s[3 * 65]); o.z = pk2(s[4 * 65], s[5 * 65]); o.w = pk2(s[6 * 65], s[7 * 65]);
            *(u32x4*)(t.WT + (size_t)(t.d0 + n) * K + t.k0 + 8 * c) = o; } }
    LDS_WAIT(); asm volatile("" ::: "memory");
}
template <bool ILV = false, bool O8 = false> __device__ __forceinline__ void convert_matrix(const float* W, int batch, int K, int N, int Npad, bf16_t* WT, LAS float* scr, int gw, int NGW, int lane, float osc = 1.0f) {
    const int per = (K / 64) * (Npad / 64), total = batch * per;
    int it = gw; if (it >= total) return;
    f32x4 va[16], vb[16];
    TrItem<ILV> ta = tr_decode<ILV, O8>(W, per, K, N, Npad, WT, it), tb = ta;
    tr_load<ILV>(va, ta, N, lane);
    for (;;) {
        int nx = it + NGW; const bool hb = nx < total;
        if (hb) { tb = tr_decode<ILV, O8>(W, per, K, N, Npad, WT, nx); tr_load<ILV>(vb, tb, N, lane); }
        tr_store<ILV, O8>(va, ta, K, scr, lane, osc);
        if (!hb) break;
        it = nx; nx = it + NGW; const bool ha = nx < total;
        if (ha) { ta = tr_decode<ILV, O8>(W, per, K, N, Npad, WT, nx); tr_load<ILV>(va, ta, N, lane); }
        tr_store<ILV, O8>(vb, tb, K, scr, lane, osc);
        if (!ha) break;
        it = nx;
    }
}
__device__ __forceinline__ void rmsnorm_rows_bf16(const float* X, const float* g, bf16_t* O, int gw, int NGW, int lane) {
    f32x4 gg[16];
#pragma unroll
    for (int j = 0; j < 16; ++j) gg[j] = ((const f32x4*)g)[lane + 64 * j];
    f32x4 nx[16];
    if (gw < M) { const f32x4* xr = (const f32x4*)(X + (size_t)gw * D) + lane;
#pragma unroll
        for (int j = 0; j < 16; ++j) nx[j] = xr[64 * j]; }
    for (int m = gw; m < M; m += NGW) {
        f32x4 v[16]; float s = 0.f;
#pragma unroll
        for (int j = 0; j < 16; ++j) { v[j] = nx[j]; s += (v[j].x * v[j].x + v[j].y * v[j].y) + (v[j].z * v[j].z + v[j].w * v[j].w); }
        if (m + NGW < M) { const f32x4* xn = (const f32x4*)(X + (size_t)(m + NGW) * D) + lane;
#pragma unroll
            for (int j = 0; j < 16; ++j) nx[j] = xn[64 * j]; }
        const float rstd = 1.0f / sqrtf(wave_sum(s) * (1.0f / D) + RMS_EPS);
        u32x2* o8 = (u32x2*)(O + (size_t)m * D) + lane;
#pragma unroll
        for (int j = 0; j < 16; ++j) { u32x2 w; w.x = pk2(v[j].x * rstd * gg[j].x, v[j].y * rstd * gg[j].y); w.y = pk2(v[j].z * rstd * gg[j].z, v[j].w * rstd * gg[j].w); o8[64 * j] = w; }
    }
}
template <int OUTM  > __device__ __forceinline__ void rmsnorm_rows_from_bf16(const bf16_t* X, const float* g, void* O, int gw, int NGW, int lane) {
    f32x4 gg[8][2];
#pragma unroll
    for (int j = 0; j < 8; ++j) { const int c0 = 8 * (lane + 64 * j); gg[j][0] = *(const f32x4*)(g + c0); gg[j][1] = *(const f32x4*)(g + c0 + 4); }
    u32x4 w[8];
    if (gw < M) { const u32x4* xr = (const u32x4*)(X + (size_t)gw * D) + lane;
#pragma unroll
        for (int j = 0; j < 8; ++j) w[j] = xr[64 * j]; }
    for (int m = gw; m < M; m += NGW) {
        float v[8][8]; float s = 0.f;
#pragma unroll
        for (int j = 0; j < 8; ++j) { v[j][0] = bflo(w[j].x); v[j][1] = bfhi(w[j].x); v[j][2] = bflo(w[j].y); v[j][3] = bfhi(w[j].y); v[j][4] = bflo(w[j].z); v[j][5] = bfhi(w[j].z); v[j][6] = bflo(w[j].w); v[j][7] = bfhi(w[j].w);
#pragma unroll
            for (int e = 0; e < 8; ++e) s += v[j][e] * v[j][e]; }
        if (m + NGW < M) { const u32x4* xn = (const u32x4*)(X + (size_t)(m + NGW) * D) + lane;
#pragma unroll
            for (int j = 0; j < 8; ++j) w[j] = xn[64 * j]; }
        const float rstd = 1.0f / sqrtf(wave_sum(s) * (1.0f / D) + RMS_EPS);
#pragma unroll
        for (int j = 0; j < 8; ++j) { const int c0 = 8 * (lane + 64 * j); const f32x4 g0 = gg[j][0], g1 = gg[j][1];
            const float o0 = v[j][0] * rstd * g0.x, o1 = v[j][1] * rstd * g0.y, o2 = v[j][2] * rstd * g0.z, o3 = v[j][3] * rstd * g0.w, o4 = v[j][4] * rstd * g1.x, o5 = v[j][5] * rstd * g1.y, o6 = v[j][6] * rstd * g1.z, o7 = v[j][7] * rstd * g1.w;
            if (OUTM == 1) { float* op = (float*)O + (size_t)m * D + c0; *(f32x4*)op = (f32x4){o0, o1, o2, o3}; *(f32x4*)(op + 4) = (f32x4){o4, o5, o6, o7}; }
            else if (OUTM == 2) { u32x2 ow; ow.x = pack4_fp8(o0 * HN8_SC, o1 * HN8_SC, o2 * HN8_SC, o3 * HN8_SC); ow.y = pack4_fp8(o4 * HN8_SC, o5 * HN8_SC, o6 * HN8_SC, o7 * HN8_SC); *(u32x2*)((unsigned char*)O + (size_t)m * D + c0) = ow; }
            else { u32x4 ow; ow.x = pk2(o0, o1); ow.y = pk2(o2, o3); ow.z = pk2(o4, o5); ow.w = pk2(o6, o7); *(u32x4*)((bf16_t*)O + (size_t)m * D + c0) = ow; } }
    }
}
__device__ __forceinline__ void rmsnorm_rows_f32(const float* X, const float* g, float* O, int gw, int NGW, int lane) {
    for (int m = gw; m < M; m += NGW) {
        const f32x4* xr = (const f32x4*)(X + (size_t)m * D) + lane;
        f32x4 v[16]; float s = 0.f;
#pragma unroll
        for (int j = 0; j < 16; ++j) { v[j] = xr[64 * j]; s += (v[j].x * v[j].x + v[j].y * v[j].y) + (v[j].z * v[j].z + v[j].w * v[j].w); }
        const float rstd = 1.0f / sqrtf(wave_sum(s) * (1.0f / D) + RMS_EPS);
        f32x4* o = (f32x4*)(O + (size_t)m * D) + lane;
#pragma unroll
        for (int j = 0; j < 16; ++j) { const f32x4 gg = ((const f32x4*)g)[lane + 64 * j]; o[64 * j] = v[j] * rstd * gg; }
    }
}

__device__ __forceinline__ void gla_pre_unit(int cidx, int h, bf16_t* Q, bf16_t* Kb, const float* A1, const float* w_a2, const float* b_a, bf16_t* KT, float* EBL, LAS float* tot, int tid) {
    const int dg = tid & 31, tq = tid >> 5; const int d0 = h * 256 + 8 * dg; const int m0 = cidx * 64 + 4 * tq;
    float acc[4][8];
    { const f32x4 b0 = *(const f32x4*)(b_a + d0), b1 = *(const f32x4*)(b_a + d0 + 4);
#pragma unroll
      for (int i = 0; i < 4; ++i) { acc[i][0] = b0.x; acc[i][1] = b0.y; acc[i][2] = b0.z; acc[i][3] = b0.w; acc[i][4] = b1.x; acc[i][5] = b1.y; acc[i][6] = b1.z; acc[i][7] = b1.w; } }
#pragma unroll
    for (int jq = 0; jq < 4; ++jq) {
        f32x4 a[4];
#pragma unroll
        for (int i = 0; i < 4; ++i) a[i] = *(const f32x4*)(A1 + (size_t)(m0 + i) * 16 + 4 * jq);
#pragma unroll
        for (int jj = 0; jj < 4; ++jj) { const int j = 4 * jq + jj;
            const f32x4 w0 = *(const f32x4*)(w_a2 + (size_t)j * 2048 + d0), w1 = *(const f32x4*)(w_a2 + (size_t)j * 2048 + d0 + 4);
#pragma unroll
            for (int i = 0; i < 4; ++i) { const float av = a[i][jj];
                acc[i][0] += av * w0.x; acc[i][1] += av * w0.y; acc[i][2] += av * w0.z; acc[i][3] += av * w0.w; acc[i][4] += av * w1.x; acc[i][5] += av * w1.y; acc[i][6] += av * w1.z; acc[i][7] += av * w1.w; } }
    }
#pragma unroll
    for (int i = 0; i < 4; ++i)
#pragma unroll
        for (int e = 0; e < 8; ++e) { const float x = acc[i][e]; acc[i][e] = (fminf(x, 0.f) - log1pf(__expf(-fabsf(x)))) * (1.0f / 16.0f); }
#pragma unroll
    for (int i = 1; i < 4; ++i)
#pragma unroll
        for (int e = 0; e < 8; ++e) acc[i][e] += acc[i - 1][e];
    *(LAS f32x4*)(tot + tq * 256 + 8 * dg) = (f32x4){acc[3][0], acc[3][1], acc[3][2], acc[3][3]};
    *(LAS f32x4*)(tot + tq * 256 + 8 * dg + 4) = (f32x4){acc[3][4], acc[3][5], acc[3][6], acc[3][7]};
    __syncthreads();
    float pre[8], all[8];
#pragma unroll
    for (int e = 0; e < 8; ++e) { pre[e] = 0.f; all[e] = 0.f; }
#pragma unroll
    for (int q = 0; q < 16; ++q) { const f32x4 t0 = *(const LAS f32x4*)(tot + q * 256 + 8 * dg), t1 = *(const LAS f32x4*)(tot + q * 256 + 8 * dg + 4);
        const float tv[8] = {t0.x, t0.y, t0.z, t0.w, t1.x, t1.y, t1.z, t1.w};
#pragma unroll
        for (int e = 0; e < 8; ++e) { all[e] += tv[e]; if (q < tq) pre[e] += tv[e]; } }
    float kv[4][8];
#pragma unroll
    for (int i = 0; i < 4; ++i) { const size_t off = (size_t)(m0 + i) * 2048 + d0;
        const u32x4 qw = *(const u32x4*)(Q + off), kw = *(const u32x4*)(Kb + off);
        const unsigned qa[4] = {qw.x, qw.y, qw.z, qw.w}, ka[4] = {kw.x, kw.y, kw.z, kw.w};
        float qo[8];
#pragma unroll
        for (int e2 = 0; e2 < 4; ++e2) { const float b0 = pre[2 * e2] + acc[i][2 * e2], b1 = pre[2 * e2 + 1] + acc[i][2 * e2 + 1];
            qo[2 * e2] = bflo(qa[e2]) * __expf(b0) * 0.0625f; qo[2 * e2 + 1] = bfhi(qa[e2]) * __expf(b1) * 0.0625f;
            kv[i][2 * e2] = bflo(ka[e2]) * __expf(-b0); kv[i][2 * e2 + 1] = bfhi(ka[e2]) * __expf(-b1); }
        u32x4 qs, ks; qs.x = pk2(qo[0], qo[1]); qs.y = pk2(qo[2], qo[3]); qs.z = pk2(qo[4], qo[5]); qs.w = pk2(qo[6], qo[7]);
        ks.x = pk2(kv[i][0], kv[i][1]); ks.y = pk2(kv[i][2], kv[i][3]); ks.z = pk2(kv[i][4], kv[i][5]); ks.w = pk2(kv[i][6], kv[i][7]);
        *(u32x4*)(Q + off) = qs; *(u32x4*)(Kb + off) = ks; }
#pragma unroll
    for (int e = 0; e < 8; ++e) { u32x2 w; w.x = pk2(kv[0][e], kv[1][e]); w.y = pk2(kv[2][e], kv[3][e]); *(u32x2*)(KT + ((size_t)cidx * 2048 + d0 + e) * 64 + 4 * tq) = w; }
    if (tq == 0) { *(f32x4*)(EBL + (size_t)cidx * 2048 + d0) = (f32x4){__expf(all[0]), __expf(all[1]), __expf(all[2]), __expf(all[3])};
                   *(f32x4*)(EBL + (size_t)cidx * 2048 + d0 + 4) = (f32x4){__expf(all[4]), __expf(all[5]), __expf(all[6]), __expf(all[7])}; }
    __syncthreads();
}

constexpr int SC_LQ = 0, SC_LK = 33792, SC_LKT = 67584, SC_LVT = 104448, SC_LP = 113664, SC_LST = 122880, SC_LEBL = 156672;
static_assert(SC_LEBL + 1024 <= MISC_OFF, "scan LDS map");
struct ScanRegs { u32x4 q[4], k[4], kt[4], v; float ebl; };
__device__ __forceinline__ void gla_scan_load(ScanRegs& R, int cidx, int h, int vs, const bf16_t* Q, const bf16_t* Kb, const bf16_t* KT, const bf16_t* V, const float* EBL, int tid) {
#pragma unroll
    for (int i = 0; i < 4; ++i) { const int idx = tid + 512 * i, row = idx >> 5, ch = idx & 31; const size_t off = (size_t)(cidx * 64 + row) * 2048 + h * 256 + ch * 8;
        R.q[i] = *(const u32x4*)(Q + off); R.k[i] = *(const u32x4*)(Kb + off); }
#pragma unroll
    for (int i = 0; i < 4; ++i) { const int idx = tid + 512 * i, row = idx >> 3, ch = idx & 7;
        R.kt[i] = *(const u32x4*)(KT + ((size_t)cidx * 2048 + h * 256 + row) * 64 + ch * 8); }
    { const int s = tid >> 3, ch = tid & 7; R.v = *(const u32x4*)(V + (size_t)(cidx * 64 + s) * 4096 + h * 512 + vs * 64 + ch * 8); }
    R.ebl = EBL[(size_t)cidx * 2048 + h * 256 + (tid & 255)];
}
__device__ __forceinline__ void gla_scan_store(const ScanRegs& R, LAS unsigned char* lds, int tid) {
#pragma unroll
    for (int i = 0; i < 4; ++i) { const int idx = tid + 512 * i, row = idx >> 5, ch = idx & 31;
        *(LAS u32x4*)(lds + SC_LQ + row * 528 + ch * 16) = R.q[i]; *(LAS u32x4*)(lds + SC_LK + row * 528 + ch * 16) = R.k[i]; }
#pragma unroll
    for (int i = 0; i < 4; ++i) { const int idx = tid + 512 * i, row = idx >> 3, ch = idx & 7;
        *(LAS u32x4*)(lds + SC_LKT + row * 144 + ch * 16) = R.kt[i]; }
    { const int s = tid >> 3, ch = tid & 7; const unsigned va[4] = {R.v.x, R.v.y, R.v.z, R.v.w};
#pragma unroll
      for (int e2 = 0; e2 < 4; ++e2) { *(LAS bf16_t*)(lds + SC_LVT + (ch * 8 + 2 * e2) * 144 + s * 2) = (bf16_t)(va[e2] & 0xffffu); *(LAS bf16_t*)(lds + SC_LVT + (ch * 8 + 2 * e2 + 1) * 144 + s * 2) = (bf16_t)(va[e2] >> 16); } }
    if (tid < 256) ((LAS float*)(lds + SC_LEBL))[tid] = R.ebl;
}
__device__ __forceinline__ void gla_scan_unit(int b, int h, int vs, const bf16_t* Q, const bf16_t* Kb, const bf16_t* KT, const bf16_t* V, const float* EBL, bf16_t* ORAW, LAS unsigned char* lds, int tid) {
    const int lane = tid & 63, w = __builtin_amdgcn_readfirstlane(tid >> 6), fr = lane & 15, fq = lane >> 4;
    f32x4 S[2][4];
#pragma unroll
    for (int a = 0; a < 2; ++a)
#pragma unroll
        for (int n = 0; n < 4; ++n) S[a][n] = (f32x4){0.f, 0.f, 0.f, 0.f};
    for (int i = tid; i < 33792 / 16; i += NTHR) ((LAS u32x4*)(lds + SC_LST))[i] = (u32x4){0u, 0u, 0u, 0u};
    ScanRegs R;
    gla_scan_load(R, b * 128, h, vs, Q, Kb, KT, V, EBL, tid);
    gla_scan_store(R, lds, tid);
    const int mt = w >> 1, nt0 = 2 * (w & 1);
    for (int c = 0; c < 128; ++c) {
        const int cidx = b * 128 + c;
        if (c + 1 < 128) gla_scan_load(R, cidx + 1, h, vs, Q, Kb, KT, V, EBL, tid);
        __syncthreads();
#pragma unroll
        for (int q = 0; q < 2; ++q) { const int nt = nt0 + q; f32x4 acc = (f32x4){0.f, 0.f, 0.f, 0.f};
            if (nt <= mt) {
#pragma unroll
                for (int ks = 0; ks < 8; ++ks) acc = mfma16(lfrag(lds + SC_LQ, 16 * mt + fr, 528, 32 * ks + 8 * fq), lfrag(lds + SC_LK, 16 * nt + fr, 528, 32 * ks + 8 * fq), acc); }
#pragma unroll
            for (int r = 0; r < 4; ++r) { const int t = 16 * mt + 4 * fq + r, s = 16 * nt + fr; *(LAS bf16_t*)(lds + SC_LP + t * 144 + s * 2) = (bf16_t)f2bf(s <= t ? acc[r] : 0.f); } }
        __syncthreads();
#pragma unroll
        for (int q = 0; q < 2; ++q) { const int nt = nt0 + q; f32x4 acc = (f32x4){0.f, 0.f, 0.f, 0.f};
#pragma unroll
            for (int ks = 0; ks < 2; ++ks) acc = mfma16(lfrag(lds + SC_LVT, 16 * nt + fr, 144, 32 * ks + 8 * fq), lfrag(lds + SC_LP, 16 * mt + fr, 144, 32 * ks + 8 * fq), acc);
#pragma unroll
            for (int ks = 0; ks < 8; ++ks) acc = mfma16(lfrag(lds + SC_LST, 16 * nt + fr, 528, 32 * ks + 8 * fq), lfrag(lds + SC_LQ, 16 * mt + fr, 528, 32 * ks + 8 * fq), acc);
            u32x2 ow; ow.x = pk2(acc[0], acc[1]); ow.y = pk2(acc[2], acc[3]); *(u32x2*)(ORAW + (size_t)(cidx * 64 + 16 * mt + fr) * 4096 + h * 512 + vs * 64 + 16 * nt + 4 * fq) = ow; }
#pragma unroll
        for (int mi = 0; mi < 2; ++mi) { const int dt = 2 * w + mi;
#pragma unroll
            for (int ks = 0; ks < 2; ++ks) { const bf16x8 a = lfrag(lds + SC_LKT, 16 * dt + fr, 144, 32 * ks + 8 * fq);
#pragma unroll
                for (int nt = 0; nt < 4; ++nt) S[mi][nt] = mfma16(a, lfrag(lds + SC_LVT, 16 * nt + fr, 144, 32 * ks + 8 * fq), S[mi][nt]); }
            const f32x4 eb = *(const LAS f32x4*)(lds + SC_LEBL + (16 * dt + 4 * fq) * 4);
#pragma unroll
            for (int nt = 0; nt < 4; ++nt) S[mi][nt] = S[mi][nt] * eb; }
        __syncthreads();
#pragma unroll
        for (int mi = 0; mi < 2; ++mi) { const int dt = 2 * w + mi;
#pragma unroll
            for (int nt = 0; nt < 4; ++nt) { u32x2 wv; wv.x = pk2(S[mi][nt][0], S[mi][nt][1]); wv.y = pk2(S[mi][nt][2], S[mi][nt][3]);
                *(LAS u32x2*)(lds + SC_LST + (16 * nt + fr) * 528 + (16 * dt + 4 * fq) * 2) = wv; } }
        if (c + 1 < 128) gla_scan_store(R, lds, tid);
    }
    __syncthreads();
}

__device__ __forceinline__ void gla_out_norm(const bf16_t* ORAW, const bf16_t* Rg, const float* g_out, bf16_t* OG, int gw, int NGW, int lane) {
    const f32x4 g0 = *(const f32x4*)(g_out + 4 * lane), g1 = *(const f32x4*)(g_out + 256 + 4 * lane);
    for (int m = gw; m < M; m += NGW) {
        const size_t rb = (size_t)m * 4096;
        u32x2 q0[8], q1[8], r0[8], r1[8];
#pragma unroll
        for (int h = 0; h < 8; ++h) { const size_t base = rb + h * 512;
            q0[h] = *(const u32x2*)(ORAW + base + 4 * lane); q1[h] = *(const u32x2*)(ORAW + base + 256 + 4 * lane);
            r0[h] = *(const u32x2*)(Rg + base + 4 * lane); r1[h] = *(const u32x2*)(Rg + base + 256 + 4 * lane); }
#pragma unroll
        for (int h = 0; h < 8; ++h) { const size_t base = rb + h * 512;
            const f32x4 v0 = (f32x4){bflo(q0[h].x), bfhi(q0[h].x), bflo(q0[h].y), bfhi(q0[h].y)}, v1 = (f32x4){bflo(q1[h].x), bfhi(q1[h].x), bflo(q1[h].y), bfhi(q1[h].y)};
            const float s = (v0.x * v0.x + v0.y * v0.y) + (v0.z * v0.z + v0.w * v0.w) + (v1.x * v1.x + v1.y * v1.y) + (v1.z * v1.z + v1.w * v1.w);
            const float rstd = 1.0f / sqrtf(wave_sum(s) * (1.0f / 512.0f) + RMS_EPS);
            float rr[8] = {bflo(r0[h].x), bfhi(r0[h].x), bflo(r0[h].y), bfhi(r0[h].y), bflo(r1[h].x), bfhi(r1[h].x), bflo(r1[h].y), bfhi(r1[h].y)};
#pragma unroll
            for (int e = 0; e < 8; ++e) rr[e] = rr[e] / (1.0f + __expf(-rr[e]));
            u32x2 o0, o1;
            o0.x = pk2(v0.x * rstd * g0.x * rr[0], v0.y * rstd * g0.y * rr[1]); o0.y = pk2(v0.z * rstd * g0.z * rr[2], v0.w * rstd * g0.w * rr[3]);
            o1.x = pk2(v1.x * rstd * g1.x * rr[4], v1.y * rstd * g1.y * rr[5]); o1.y = pk2(v1.z * rstd * g1.z * rr[6], v1.w * rstd * g1.w * rr[7]);
            *(u32x2*)(OG + base + 4 * lane) = o0; *(u32x2*)(OG + base + 256 + 4 * lane) = o1; }
    }
}

template <bool F8OUT> __device__ __forceinline__ void conv_fixup(const bf16_t* UH, const float* cw, const float* cb, bf16_t* ACT, int gtid, int ngt) {
    constexpr int NV = DFF / 8;
    for (int idx = gtid; idx < (M / 64) * NV; idx += ngt) {
        const int g = idx / NV, cv = idx - g * NV, c = 8 * cv, pn = c >> 7, l = c & 127;
        const bool first = (g & 127) == 0;
        float a[2][8];
        float y[2][2][8];
#pragma unroll
        for (int half = 0; half < 2; ++half) {
            const int cc = c + half * DFF; const size_t hc = (size_t)pn * 256 + half * 128 + l;
            float um2[8], um1[8], u0[8], u1[8];
            const u32x4 z = (u32x4){0u, 0u, 0u, 0u};
            const u32x4 q2 = first ? z : *(const u32x4*)(UH + ((size_t)(g - 1) * 4 + 0) * DFF2 + hc), q1 = first ? z : *(const u32x4*)(UH + ((size_t)(g - 1) * 4 + 1) * DFF2 + hc);
            const u32x4 p0 = *(const u32x4*)(UH + ((size_t)g * 4 + 2) * DFF2 + hc), p1 = *(const u32x4*)(UH + ((size_t)g * 4 + 3) * DFF2 + hc);
            const unsigned q2a[4] = {q2.x, q2.y, q2.z, q2.w}, q1a[4] = {q1.x, q1.y, q1.z, q1.w}, p0a[4] = {p0.x, p0.y, p0.z, p0.w}, p1a[4] = {p1.x, p1.y, p1.z, p1.w};
#pragma unroll
            for (int e2 = 0; e2 < 4; ++e2) { um2[2 * e2] = bflo(q2a[e2]); um2[2 * e2 + 1] = bfhi(q2a[e2]); um1[2 * e2] = bflo(q1a[e2]); um1[2 * e2 + 1] = bfhi(q1a[e2]);
                u0[2 * e2] = bflo(p0a[e2]); u0[2 * e2 + 1] = bfhi(p0a[e2]); u1[2 * e2] = bflo(p1a[e2]); u1[2 * e2 + 1] = bfhi(p1a[e2]); }
#pragma unroll
            for (int e = 0; e < 8; ++e) { const float w0 = cw[cc + e], w1 = cw[DFF2 + cc + e], w2 = cw[2 * DFF2 + cc + e], bb = cb[cc + e];
                y[0][half][e] = bb + w0 * um2[e] + w1 * um1[e] + w2 * u0[e];
                y[1][half][e] = bb + w0 * um1[e] + w1 * u0[e] + w2 * u1[e]; }
        }
#pragma unroll
        for (int r = 0; r < 2; ++r) {
#pragma unroll
            for (int e = 0; e < 8; ++e) a[r][e] = y[r][0][e] / (1.0f + __expf(-y[r][0][e])) * y[r][1][e];
            if (F8OUT) { u32x2 o; o.x = pack4_fp8(a[r][0] * ACT_SC, a[r][1] * ACT_SC, a[r][2] * ACT_SC, a[r][3] * ACT_SC); o.y = pack4_fp8(a[r][4] * ACT_SC, a[r][5] * ACT_SC, a[r][6] * ACT_SC, a[r][7] * ACT_SC);
                *(u32x2*)((unsigned char*)ACT + (size_t)(64 * g + r) * DFF + c) = o; }
            else { u32x4 o; o.x = pk2(a[r][0], a[r][1]); o.y = pk2(a[r][2], a[r][3]); o.z = pk2(a[r][4], a[r][5]); o.w = pk2(a[r][6], a[r][7]);
                *(u32x4*)(ACT + (size_t)(64 * g + r) * DFF + c) = o; } }
    }
}

__device__ __forceinline__ void dsa_norm(const float* Z, const float* g_q, const float* g_kv, bf16_t* CQN, bf16_t* CKV, bf16_t* KIDX, float* WIDX, int gw, int NGW, int lane) {
    f32x4 gq[4], gk[2];
#pragma unroll
    for (int j = 0; j < 4; ++j) gq[j] = *(const f32x4*)(g_q + 4 * (lane + 64 * j));
#pragma unroll
    for (int j = 0; j < 2; ++j) gk[j] = *(const f32x4*)(g_kv + 4 * (lane + 64 * j));
    f32x4 nq[4], nkv[2], nk = (f32x4){0.f, 0.f, 0.f, 0.f}, nw = nk;
#define DSA_LOADROW(mm) do { const float* z_ = Z + (size_t)(mm) * DSA_IN_NP; _Pragma("unroll") for (int j = 0; j < 4; ++j) nq[j] = *(const f32x4*)(z_ + 4 * (lane + 64 * j)); \
        _Pragma("unroll") for (int j = 0; j < 2; ++j) nkv[j] = *(const f32x4*)(z_ + 1024 + 4 * (lane + 64 * j)); \
        nk = *(const f32x4*)(z_ + 1536 + 4 * (lane & 31)); nw = *(const f32x4*)(z_ + 1664 + 4 * (lane & 15)); } while (0)
    if (gw < M) DSA_LOADROW(gw);
    for (int m = gw; m < M; m += NGW) {
        f32x4 q[4], kv[2]; const f32x4 k = nk, wv = nw; float s = 0.f, s2 = 0.f;
#pragma unroll
        for (int j = 0; j < 4; ++j) { q[j] = nq[j]; s += (q[j].x * q[j].x + q[j].y * q[j].y) + (q[j].z * q[j].z + q[j].w * q[j].w); }
#pragma unroll
        for (int j = 0; j < 2; ++j) { kv[j] = nkv[j]; s2 += (kv[j].x * kv[j].x + kv[j].y * kv[j].y) + (kv[j].z * kv[j].z + kv[j].w * kv[j].w); }
        if (m + NGW < M) DSA_LOADROW(m + NGW);
        const float rq = 1.0f / sqrtf(wave_sum(s) * (1.0f / 1024.0f) + RMS_EPS);
#pragma unroll
        for (int j = 0; j < 4; ++j) { const f32x4 gg = gq[j]; u32x2 w; w.x = pk2(q[j].x * rq * gg.x, q[j].y * rq * gg.y); w.y = pk2(q[j].z * rq * gg.z, q[j].w * rq * gg.w);
            *(u32x2*)(CQN + (size_t)m * 1024 + 4 * (lane + 64 * j)) = w; }
        const float rk = 1.0f / sqrtf(wave_sum(s2) * (1.0f / 512.0f) + RMS_EPS);
#pragma unroll
        for (int j = 0; j < 2; ++j) { const f32x4 gg = gk[j]; u32x2 w; w.x = pk2(kv[j].x * rk * gg.x, kv[j].y * rk * gg.y); w.y = pk2(kv[j].z * rk * gg.z, kv[j].w * rk * gg.w);
            *(u32x2*)(CKV + (size_t)m * 512 + 4 * (lane + 64 * j)) = w; }
        if (lane < 32) { u32x2 w; w.x = pk2(k.x, k.y); w.y = pk2(k.z, k.w); *(u32x2*)(KIDX + (size_t)m * 128 + 4 * lane) = w; }
        if (lane < 16) { *(f32x4*)(WIDX + (size_t)m * 64 + 4 * lane) = wv * 0.01104854345603981f; }
    }
#undef DSA_LOADROW
}

constexpr int IX_PITCH = 272, IX_BUF = 64 * IX_PITCH;
__device__ __forceinline__ void indexer_group(int u, const bf16_t* QIDX, const bf16_t* KIDX, const float* WIDX, float* SCo, LAS unsigned char* lds, int tid) {
    const int lane = tid & 63, w = __builtin_amdgcn_readfirstlane(tid >> 6), fr = lane & 15, fq = lane >> 4;
    const int m0 = 16 * u, b = m0 >> 13, t0 = m0 & (SEQ - 1);
    if (t0 + 15 < 256) return;
    const int ng = (t0 + 15 + 64) >> 6;
    const int mA = m0 + 2 * w;
    bf16x8 a[2][4][4]; f32x4 wv[2][4]; bf16x8 abar[4];
#pragma unroll
    for (int ks = 0; ks < 4; ++ks) abar[ks] = (bf16x8){0, 0, 0, 0, 0, 0, 0, 0};
#pragma unroll
    for (int tk = 0; tk < 2; ++tk) {
        float qs[4][8];
#pragma unroll
        for (int ks = 0; ks < 4; ++ks)
#pragma unroll
            for (int e = 0; e < 8; ++e) qs[ks][e] = 0.f;
#pragma unroll
        for (int mt = 0; mt < 4; ++mt) {
            const float wrow = 0.5f * WIDX[(size_t)(mA + tk) * 64 + 16 * mt + fr];
#pragma unroll
            for (int ks = 0; ks < 4; ++ks) { a[tk][mt][ks] = *(const bf16x8*)(QIDX + (size_t)(mA + tk) * 8192 + (16 * mt + fr) * 128 + 32 * ks + 8 * fq);
                const u32x4 aw = __builtin_bit_cast(u32x4, a[tk][mt][ks]);
                qs[ks][0] += wrow * bflo(aw.x); qs[ks][1] += wrow * bfhi(aw.x); qs[ks][2] += wrow * bflo(aw.y); qs[ks][3] += wrow * bfhi(aw.y);
                qs[ks][4] += wrow * bflo(aw.z); qs[ks][5] += wrow * bfhi(aw.z); qs[ks][6] += wrow * bflo(aw.w); qs[ks][7] += wrow * bfhi(aw.w); }
            wv[tk][mt] = *(const f32x4*)(WIDX + (size_t)(mA + tk) * 64 + 16 * mt + 4 * fq) * 0.5f; }
#pragma unroll
        for (int ks = 0; ks < 4; ++ks) {
#pragma unroll
            for (int e = 0; e < 8; ++e) { float v = qs[ks][e];
                v += __builtin_bit_cast(float, __builtin_amdgcn_update_dpp(0, __builtin_bit_cast(int, v), 0xB1, 0xf, 0xf, false));
                v += __builtin_bit_cast(float, __builtin_amdgcn_update_dpp(0, __builtin_bit_cast(int, v), 0x4E, 0xf, 0xf, false));
                v += __builtin_bit_cast(float, __builtin_amdgcn_update_dpp(0, __builtin_bit_cast(int, v), 0x141, 0xf, 0xf, false));
                v += __builtin_bit_cast(float, __builtin_amdgcn_update_dpp(0, __builtin_bit_cast(int, v), 0x140, 0xf, 0xf, false));
                qs[ks][e] = v; }
            const u32x4 pkd = (u32x4){pk2(qs[ks][0], qs[ks][1]), pk2(qs[ks][2], qs[ks][3]), pk2(qs[ks][4], qs[ks][5]), pk2(qs[ks][6], qs[ks][7])};
            if (fr == tk) abar[ks] = __builtin_bit_cast(bf16x8, pkd); }
    }
    const int krow = tid >> 3, kc = (tid & 7) * 2;
    const bf16_t* kp = KIDX + ((size_t)b * SEQ + krow) * 128 + kc * 8;
    u32x4 r0 = *(const u32x4*)kp, r1 = *(const u32x4*)(kp + 8);
    *(LAS u32x4*)(lds + krow * IX_PITCH + kc * 16) = r0; *(LAS u32x4*)(lds + krow * IX_PITCH + kc * 16 + 16) = r1;
    __syncthreads();
    for (int g = 0; g < ng; ++g) {
        if (g + 1 < ng) { const bf16_t* kn = kp + (size_t)(g + 1) * 64 * 128; r0 = *(const u32x4*)kn; r1 = *(const u32x4*)(kn + 8); }
        const LAS unsigned char* cur = lds + (g & 1) * IX_BUF;
        float p[2][4];
        bf16x8 bb[4];
#pragma unroll
        for (int ks = 0; ks < 4; ++ks) bb[ks] = *(const LAS bf16x8*)(cur + fr * IX_PITCH + (4 * ks + fq) * 16);
#pragma unroll
        for (int nt = 0; nt < 4; ++nt) {
            float pn[2] = {0.f, 0.f};
            f32x4 acc[5][2];
#pragma unroll
            for (int st = 0; st < 24; ++st) {
                if (st < 20) { const int q = st >> 2, ks = st & 3;
#pragma unroll
                    for (int j = 0; j < 2; ++j) { const int ch = 2 * q + j; if (ch < 9) {
                        const bf16x8 af = ch == 0 ? abar[ks] : a[(ch - 1) >> 2][(ch - 1) & 3][ks];
                        acc[q][j] = mfma16(af, bb[ks], ks ? acc[q][j] : (f32x4){0.f, 0.f, 0.f, 0.f}); } }
                }
                if (st >= 4) { const int q = (st - 4) >> 2, el = (st - 4) & 3;
#pragma unroll
                    for (int j = 0; j < 2; ++j) { const int ch = 2 * q + j; if (ch < 9) {
                        if (ch == 0) { if (el < 2) pn[el] = fq == 0 ? acc[0][0][el] : 0.f; }
                        else { const int tk = (ch - 1) >> 2, mt = (ch - 1) & 3; pn[tk] = __builtin_fmaf(__builtin_fabsf(acc[q][j][el]), wv[tk][mt][el], pn[tk]); } } }
                }
                if (st == 20 && nt < 3) {
#pragma unroll
                    for (int k2 = 0; k2 < 4; ++k2) bb[k2] = *(const LAS bf16x8*)(cur + (16 * (nt + 1) + fr) * IX_PITCH + (4 * k2 + fq) * 16); }
                __builtin_amdgcn_sched_barrier(0);
            }
            p[0][nt] = pn[0]; p[1][nt] = pn[1];
        }
#pragma unroll
        for (int tk = 0; tk < 2; ++tk) {
            const float k0 = swapsum32(p[tk][0], p[tk][2]), k1 = swapsum32(p[tk][1], p[tk][3]);
            const float keep = swapsum16(k0, k1);
            SCo[(size_t)(mA + tk) * SEQ + 64 * g + lane] = keep; }
        if (g + 1 < ng) { LAS unsigned char* nx = lds + ((g + 1) & 1) * IX_BUF; *(LAS u32x4*)(nx + krow * IX_PITCH + kc * 16) = r0; *(LAS u32x4*)(nx + krow * IX_PITCH + kc * 16 + 16) = r1; }
        __syncthreads();
    }
}

__device__ __forceinline__ unsigned ord_key(float f) { const unsigned u = __builtin_bit_cast(unsigned, f); return u ^ ((u >> 31) ? 0xFFFFFFFFu : 0x80000000u); }
__device__ __forceinline__ int wave_sum_i(int v) {
    v += __builtin_amdgcn_update_dpp(0, v, 0xB1, 0xf, 0xf, false);
    v += __builtin_amdgcn_update_dpp(0, v, 0x4E, 0xf, 0xf, false);
    v += __builtin_amdgcn_update_dpp(0, v, 0x141, 0xf, 0xf, false);
    v += __builtin_amdgcn_update_dpp(0, v, 0x140, 0xf, 0xf, false);
    return __builtin_amdgcn_readlane(v, 0) + __builtin_amdgcn_readlane(v, 16) + __builtin_amdgcn_readlane(v, 32) + __builtin_amdgcn_readlane(v, 48);
}
__device__ __forceinline__ void topk_token(int m, const float* SCi, int* SEL, int lane) {
    const int t = m & (SEQ - 1), n = t + 1; int* sel = SEL + (size_t)m * 256;
    if (n <= 256) {
#pragma unroll
        for (int j = 0; j < 4; ++j) { const int i = lane + 64 * j; sel[i] = i < n ? i : -1; }
        return; }
    const float* sc = SCi + (size_t)m * SEQ;
    const int nq = (n + 255) >> 8;
    unsigned key[32][4];
    f32x4 raw[32];
#pragma unroll
    for (int j = 0; j < 32; ++j) raw[j] = *(const f32x4*)(sc + 256 * (j < nq ? j : 0) + 4 * lane);
#pragma unroll
    for (int j = 0; j < 32; ++j) { const int i0 = 256 * j + 4 * lane;
        key[j][0] = i0 < n ? ord_key(raw[j].x) : 0u; key[j][1] = i0 + 1 < n ? ord_key(raw[j].y) : 0u; key[j][2] = i0 + 2 < n ? ord_key(raw[j].z) : 0u; key[j][3] = i0 + 3 < n ? ord_key(raw[j].w) : 0u; }
    unsigned prefix = 0u;
#pragma unroll 1
    for (int bit = 31; bit >= 0; --bit) {
        const unsigned cand = prefix | (1u << bit); int cnt = 0; int cntv = 0;
#pragma unroll
        for (int jg = 0; jg < 4; ++jg) if (8 * jg < nq) {
#pragma unroll
            for (int j = 8 * jg; j < 8 * jg + 8; j += 2) {
                unsigned long long bm[5];
#pragma unroll
                for (int e = 0; e < 3; ++e) bm[e] = __ballot(key[j][e] >= cand);
                bm[3] = __ballot(key[j + 1][0] >= cand); bm[4] = __ballot(key[j + 1][1] >= cand);
                asm("v_cmp_le_u32 vcc, %1, %2\n\tv_addc_co_u32 %0, vcc, 0, %0, vcc" : "+v"(cntv) : "s"(cand), "v"(key[j][3]) : "vcc");
                asm("v_cmp_le_u32 vcc, %1, %2\n\tv_addc_co_u32 %0, vcc, 0, %0, vcc" : "+v"(cntv) : "s"(cand), "v"(key[j + 1][2]) : "vcc");
                asm("v_cmp_le_u32 vcc, %1, %2\n\tv_addc_co_u32 %0, vcc, 0, %0, vcc" : "+v"(cntv) : "s"(cand), "v"(key[j + 1][3]) : "vcc");
                __builtin_amdgcn_sched_barrier(0);
#pragma unroll
                for (int e = 0; e < 5; ++e) cnt += __builtin_popcountll(bm[e]);
                __builtin_amdgcn_sched_barrier(0); } }
        cnt += wave_sum_i(cntv);
        if (cnt >= 256) { prefix = cand; if (cnt == 256) break; }
    }
    const unsigned T = prefix;
    int cgts = 0;
#pragma unroll
    for (int jg = 0; jg < 4; ++jg) if (8 * jg < nq) {
#pragma unroll
        for (int j = 8 * jg; j < 8 * jg + 8; ++j)
#pragma unroll
            for (int e = 0; e < 4; ++e) cgts += __builtin_popcountll(__ballot(key[j][e] > T)); }
    const int want = 256 - cgts;
    int base = 0, eqtaken = 0;
    const unsigned long long ltmask = (1ull << lane) - 1ull;
#pragma unroll
    for (int j = 0; j < 32; ++j) if (j < nq) {
        const bool e0 = key[j][0] == T, e1 = key[j][1] == T, e2 = key[j][2] == T, e3 = key[j][3] == T;
        const int ecl = (int)e0 + (int)e1 + (int)e2 + (int)e3;
        const unsigned long long anyeq = __ballot(ecl != 0);
        int eqlow = 0, eqall = 0;
        if (anyeq) { int x = ecl;
#pragma unroll
            for (int off = 1; off < 64; off <<= 1) { const int y = __shfl_up(x, off); if (lane >= off) x += y; }
            eqlow = x - ecl; eqall = __shfl(x, 63); }
        const int r0 = eqtaken + eqlow;
        const bool t0 = key[j][0] > T || (e0 && r0 < want);
        const bool t1 = key[j][1] > T || (e1 && r0 + (int)e0 < want);
        const bool t2 = key[j][2] > T || (e2 && r0 + (int)e0 + (int)e1 < want);
        const bool t3 = key[j][3] > T || (e3 && r0 + (int)e0 + (int)e1 + (int)e2 < want);
        const unsigned long long b0 = __ballot(t0), b1 = __ballot(t1), b2 = __ballot(t2), b3 = __ballot(t3);
        const int i0 = 256 * j + 4 * lane; int pos = base + __builtin_popcountll(b0 & ltmask);
        if (t0 && pos < 256) sel[pos] = i0;
        base += __builtin_popcountll(b0); pos = base + __builtin_popcountll(b1 & ltmask);
        if (t1 && pos < 256) sel[pos] = i0 + 1;
        base += __builtin_popcountll(b1); pos = base + __builtin_popcountll(b2 & ltmask);
        if (t2 && pos < 256) sel[pos] = i0 + 2;
        base += __builtin_popcountll(b2); pos = base + __builtin_popcountll(b3 & ltmask);
        if (t3 && pos < 256) sel[pos] = i0 + 3;
        base += __builtin_popcountll(b3); eqtaken += eqall;
    }
}

template <int KSTEPS, int NB>
__device__ __forceinline__ void thin_gemm_wave(const bf16_t* A, size_t lda, const bf16_t* Bt, bf16_t* C, size_t ldc, int lane) {
    const int fr = lane & 15, fq = lane >> 4; constexpr int K = 32 * KSTEPS;
    bf16x8 a[2][KSTEPS];
#pragma unroll
    for (int mi = 0; mi < 2; ++mi)
#pragma unroll
        for (int ks = 0; ks < KSTEPS; ++ks) a[mi][ks] = *(const bf16x8*)(A + (size_t)(16 * mi + fr) * lda + 32 * ks + 8 * fq);
    for (int nt = 0; nt < NB * 4; ++nt) {
        f32x4 acc0 = (f32x4){0.f, 0.f, 0.f, 0.f}, acc1 = acc0;
        const bf16_t* bp = Bt + (size_t)(16 * nt + fr) * K + 8 * fq;
#pragma unroll
        for (int ks = 0; ks < KSTEPS; ++ks) { const bf16x8 bb = *(const bf16x8*)(bp + 32 * ks); acc0 = mfma16(bb, a[0][ks], acc0); acc1 = mfma16(bb, a[1][ks], acc1); }
        u32x2 w0, w1; w0.x = pk2(acc0[0], acc0[1]); w0.y = pk2(acc0[2], acc0[3]); w1.x = pk2(acc1[0], acc1[1]); w1.y = pk2(acc1[2], acc1[3]);
        *(u32x2*)(C + (size_t)fr * ldc + 16 * nt + 4 * fq) = w0; *(u32x2*)(C + (size_t)(16 + fr) * ldc + 16 * nt + 4 * fq) = w1;
    }
}

constexpr int AT_PITCH = 1056, AT_BUF = 32 * AT_PITCH, AT_QOFF = 2 * AT_BUF, AT_XOFF = AT_QOFF + 64 * AT_PITCH;
static_assert(AT_XOFF + 8192 <= MISC_OFF, "attention LDS map");
__device__ __forceinline__ void attn_q_dma(const bf16_t* QLAT, int m, LAS unsigned char* lds, int w, int lane) {
#pragma unroll
    for (int i = 0; i < 8; ++i) __builtin_amdgcn_global_load_lds((const unsigned*)(QLAT + (size_t)m * 32768 + (8 * w + i) * 512 + lane * 8), (LAS unsigned*)(lds + AT_QOFF + (8 * w + i) * AT_PITCH), 16, 0, 0);
}
__device__ __forceinline__ void attn_fetch32(u32x4 (&g)[4], int selreg, int half, int b, const bf16_t* CKV, int w, int lane) {
#pragma unroll
    for (int i = 0; i < 4; ++i) { const int idx = __builtin_amdgcn_readlane(selreg, 32 * half + 4 * w + i);
        g[i] = *(const u32x4*)(CKV + ((size_t)b * SEQ + idx) * 512 + lane * 8); }
}
__device__ __forceinline__ void attn_put32(const u32x4 (&g)[4], int bufi, LAS unsigned char* lds, int w, int lane) {
#pragma unroll
    for (int i = 0; i < 4; ++i) *(LAS u32x4*)(lds + bufi * AT_BUF + (4 * w + i) * AT_PITCH + lane * 16) = g[i];
}
__device__ __forceinline__ void attn_load_sel(int (&s)[4], int m, const int* SEL, int lane) {
    const int t = m & (SEQ - 1), n = (t + 1 < 256) ? t + 1 : 256;
#pragma unroll
    for (int j = 0; j < 4; ++j) { const int ki = 64 * j + lane; const int v = ki < n ? SEL[(size_t)m * 256 + ki] : 0; s[j] = ((unsigned)v < (unsigned)SEQ) ? v : 0; }
}
__device__ __forceinline__ void attn_stream(int blk, int G, bf16_t* QLAT, const bf16_t* CKV, const int* SEL, LAS unsigned char* lds, int tid) {
    const int lane = tid & 63, w = __builtin_amdgcn_readfirstlane(tid >> 6), fr = lane & 15, fq = lane >> 4;
    const int ht = w & 3, chalf = w >> 2;
    const bool xl = (G == 256); const int nT = xl ? 64 : (M - blk + G - 1) / G;
#define AT_TOK(i) (xl ? ((((i) >> 5) << 13) + ((blk & 7) << 10) + (((i) & 31) << 5) + (blk >> 3)) : (blk + (i) * G))
    int scur[4], snext[4];
    attn_load_sel(scur, AT_TOK(0), SEL, lane);
    if (nT > 1) attn_load_sel(snext, AT_TOK(1), SEL, lane); else { snext[0] = 0; snext[1] = 0; snext[2] = 0; snext[3] = 0; }
    bf16x8 qa[16];
    attn_q_dma(QLAT, AT_TOK(0), lds, w, lane);
    { u32x4 g0[4]; attn_fetch32(g0, scur[0], 0, AT_TOK(0) >> 13, CKV, w, lane); attn_put32(g0, 0, lds, w, lane); }
    asm volatile("s_waitcnt vmcnt(0)" ::: "memory");
    __syncthreads();
    const int ii = lane & 15, tq = ii >> 2, tp = ii & 3;
    for (int i = 0; i < nT; ++i) {
        const int m = AT_TOK(i), mn = AT_TOK(i + 1), t = m & (SEQ - 1), n = (t + 1 < 256) ? t + 1 : 256;
        const bool more = i + 1 < nT;
        f32x4 o[16];
#pragma unroll
        for (int c = 0; c < 16; ++c) o[c] = (f32x4){0.f, 0.f, 0.f, 0.f};
        float mrun = -3.0e38f, lrun = 0.f;
#pragma unroll
        for (int ks = 0; ks < 16; ++ks) qa[ks] = lfrag(lds + AT_QOFF, 16 * ht + fr, AT_PITCH, 32 * ks + 8 * fq);
#pragma unroll
        for (int kb = 0; kb < 8; ++kb) {
            u32x4 g[4];
            if (kb == 1 && more) attn_q_dma(QLAT, mn, lds, w, lane);
            if (kb < 7) attn_fetch32(g, scur[(kb + 1) >> 1], (kb + 1) & 1, m >> 13, CKV, w, lane);
            else if (more) attn_fetch32(g, snext[0], 0, mn >> 13, CKV, w, lane);
            const LAS unsigned char* cur = lds + (kb & 1) * AT_BUF;
            if (32 * kb < n) {
                f32x4 own = (f32x4){0.f, 0.f, 0.f, 0.f};
                { bf16x8 cf[2][8];
#pragma unroll
                  for (int j = 0; j < 8; ++j) cf[0][j] = lfrag(cur, 16 * chalf + fr, AT_PITCH, 32 * j + 8 * fq);
#pragma unroll
                  for (int j = 0; j < 8; ++j) cf[1][j] = lfrag(cur, 16 * chalf + fr, AT_PITCH, 32 * (8 + j) + 8 * fq);
                  __builtin_amdgcn_sched_barrier(0);
#pragma unroll
                  for (int j = 0; j < 8; ++j) own = mfma16(cf[0][j], qa[j], own);
#pragma unroll
                  for (int j = 0; j < 8; ++j) own = mfma16(cf[1][j], qa[8 + j], own); }
                *(LAS f32x4*)(lds + AT_XOFF + (w * 64 + lane) * 16) = own;
                __syncthreads();
                const f32x4 oth = *(const LAS f32x4*)(lds + AT_XOFF + ((w ^ 4) * 64 + lane) * 16);
                f32x4 acc[2]; acc[0] = chalf == 0 ? own : oth; acc[1] = chalf == 0 ? oth : own;
                constexpr float KS = 0.08838834764831845f * 1.4426950408889634f;
                float mloc = -3.0e38f; const int lim = n - 32 * kb - 4 * fq;
                const bool full = n - 32 * kb >= 32;
                if (full) {
#pragma unroll
                    for (int km = 0; km < 2; ++km)
#pragma unroll
                        for (int r = 0; r < 4; ++r) { acc[km][r] *= KS; mloc = fmaxf(mloc, acc[km][r]); }
                } else {
#pragma unroll
                    for (int km = 0; km < 2; ++km)
#pragma unroll
                        for (int r = 0; r < 4; ++r) { const float sv = (16 * km + r) < lim ? acc[km][r] * KS : -3.0e38f; acc[km][r] = sv; mloc = fmaxf(mloc, sv); }
                }
                mloc = xmax_rows(mloc);
                const bool up = mloc > mrun + 11.0f;
                if (__any(up)) { const float mnew = up ? mloc : mrun, alpha = __builtin_amdgcn_exp2f(mrun - mnew); mrun = mnew; lrun *= alpha;
#pragma unroll
                    for (int c = 0; c < 16; ++c) o[c] = o[c] * alpha; }
                float ls = 0.f;
#pragma unroll
                for (int km = 0; km < 2; ++km)
#pragma unroll
                    for (int r = 0; r < 4; ++r) { const float pv = __builtin_amdgcn_exp2f(acc[km][r] - mrun); acc[km][r] = pv; ls += pv; }
                lrun += ls;
                const unsigned p0 = pg8::cvt_pk_bf16(acc[0][0], acc[0][1]), p1 = pg8::cvt_pk_bf16(acc[0][2], acc[0][3]), p2 = pg8::cvt_pk_bf16(acc[1][0], acc[1][1]), p3 = pg8::cvt_pk_bf16(acc[1][2], acc[1][3]);
                const bf16x8 pb = __builtin_bit_cast(bf16x8, (u32x4){p0, p1, p2, p3});
                const unsigned trb = (unsigned)(uintptr_t)(cur + (4 * fq + tq) * AT_PITCH + (256 * chalf + 4 * tp) * 2);
#define AT_TRRD(dst, off) asm volatile("ds_read_b64_tr_b16 %0, %1 offset:%2" : "=&v"(dst) : "v"(trb), "i"(off) : "memory")
#define AT_TRGRP(L, H, cg) do { AT_TRRD(L[0], 128 * (cg)); AT_TRRD(H[0], 128 * (cg) + 16 * AT_PITCH); AT_TRRD(L[1], 128 * (cg) + 32); AT_TRRD(H[1], 128 * (cg) + 32 + 16 * AT_PITCH); \
                    AT_TRRD(L[2], 128 * (cg) + 64); AT_TRRD(H[2], 128 * (cg) + 64 + 16 * AT_PITCH); AT_TRRD(L[3], 128 * (cg) + 96); AT_TRRD(H[3], 128 * (cg) + 96 + 16 * AT_PITCH); } while (0)
#define AT_TRWAIT(L, H, n) asm volatile("s_waitcnt lgkmcnt(" #n ")" : "+v"(L[0]), "+v"(L[1]), "+v"(L[2]), "+v"(L[3]), "+v"(H[0]), "+v"(H[1]), "+v"(H[2]), "+v"(H[3]) :: "memory")
#define AT_PVMMA(L, H, cg) do { _Pragma("unroll") for (int j = 0; j < 4; ++j) o[4 * (cg) + j] = mfma16((bf16x8){L[j][0], L[j][1], L[j][2], L[j][3], H[j][0], H[j][1], H[j][2], H[j][3]}, pb, o[4 * (cg) + j]); } while (0)
                { s16x4 la[4], ha[4], lb[4], hb[4];
                  AT_TRGRP(la, ha, 0); AT_TRGRP(lb, hb, 1);
                  AT_TRWAIT(la, ha, 8); __builtin_amdgcn_sched_barrier(0); AT_PVMMA(la, ha, 0); __builtin_amdgcn_sched_barrier(0);
                  AT_TRGRP(la, ha, 2);
                  AT_TRWAIT(lb, hb, 8); __builtin_amdgcn_sched_barrier(0); AT_PVMMA(lb, hb, 1); __builtin_amdgcn_sched_barrier(0);
                  AT_TRGRP(lb, hb, 3);
                  AT_TRWAIT(la, ha, 8); __builtin_amdgcn_sched_barrier(0); AT_PVMMA(la, ha, 2); __builtin_amdgcn_sched_barrier(0);
                  AT_TRWAIT(lb, hb, 0); __builtin_amdgcn_sched_barrier(0); AT_PVMMA(lb, hb, 3); }
#undef AT_TRGRP
#undef AT_TRWAIT
#undef AT_PVMMA
#undef AT_TRRD
            }
            if (kb == 7) {
                const float inv = OL_SC / xsum_rows(lrun);
                unsigned char* orow = (unsigned char*)QLAT + (size_t)m * 65536 + (16 * ht + fr) * 512 + 256 * chalf + 4 * fq;
#pragma unroll
                for (int tt = 0; tt < 16; ++tt) *(unsigned*)(orow + 16 * tt) = pack4_fp8(o[tt][0] * inv, o[tt][1] * inv, o[tt][2] * inv, o[tt][3] * inv);
                if (more) {
                    scur[0] = snext[0]; scur[1] = snext[1]; scur[2] = snext[2]; scur[3] = snext[3];
                    if (i + 2 < nT) attn_load_sel(snext, AT_TOK(i + 2), SEL, lane); }
            }
            if (kb < 7 || more) attn_put32(g, (kb + 1) & 1, lds, w, lane);
            __syncthreads();
        }
    }
#undef AT_TOK
}

#ifndef MK_ONE_LAUNCH
#define MK_ONE_LAUNCH 1
#endif
constexpr int NPH = 25;
struct Args { const float* in[20]; float* out; unsigned char* ws; int ph_lo, ph_hi; };

__global__ void __launch_bounds__(NTHR, 2) fwd(Args args) {
    extern __shared__ __attribute__((aligned(16))) unsigned char lds_raw[];
    LAS unsigned char* lds = (LAS unsigned char*)lds_raw;
    volatile LAS unsigned* MISC = (volatile LAS unsigned*)(lds + MISC_OFF);
    const int G = gridDim.x, blk = blockIdx.x, NGW = G * NWAVES;
    const int wave0 = __builtin_amdgcn_readfirstlane((int)threadIdx.x >> 6);
#define PH_IDS const int lane = hw_lane(), wave = wave0, tid = wave * 64 + lane, gw = blk * NWAVES + wave; (void)tid; (void)gw;
    unsigned char* ws = args.ws;
    unsigned* ctl = (unsigned*)(ws + WS_CTL);
    { PH_IDS for (int u = tid; u < (LDS_BYTES - MISC_OFF) / 4; u += NTHR) ((LAS unsigned*)(lds + MISC_OFF))[u] = 0u; }
    __syncthreads();
    XcdBarrier bar = xcd_barrier_post(ctl + CW_BAR, MISC + 8);
    const int lo = args.ph_lo, hi = args.ph_hi;
#define IN(k) (lo <= (k) && (k) < hi)
#define SEAM(k) do { if (IN(k) && IN((k) + 1)) xcd_barrier(bar, wave0 == 0 && hw_lane() == 0); } while (0)

    const float* x = args.in[0]; const float* g_mix = args.in[1]; const float* g_ffn = args.in[2]; const float* g_final = args.in[3];
    bf16_t* W_GLA_IN = (bf16_t*)(ws + WS_W_GLA_IN); bf16_t* W_GLA_O = (bf16_t*)(ws + WS_W_GLA_O); bf16_t* W_DSA_IN = (bf16_t*)(ws + WS_W_DSA_IN);
    bf16_t* W_QUP = (bf16_t*)(ws + WS_W_QUP); bf16_t* W_UK = (bf16_t*)(ws + WS_W_UK); bf16_t* W_UV = (bf16_t*)(ws + WS_W_UV); bf16_t* W_DSA_O = (bf16_t*)(ws + WS_W_DSA_O);
    bf16_t* W_UP = (bf16_t*)(ws + WS_W_UP); bf16_t* W_DN = (bf16_t*)(ws + WS_W_DN);
    bf16_t* H = (bf16_t*)(ws + WS_H); bf16_t* HN = (bf16_t*)(ws + WS_HN);

    if (IN(0)) { PH_IDS
        LAS float* scr = (LAS float*)(lds + wave * 16640);
        convert_matrix(args.in[4], 1, 4096, GLA_IN_N, GLA_IN_NP, W_GLA_IN, scr, gw, NGW, lane);
        rmsnorm_rows_bf16(x, g_mix, HN, gw, NGW, lane);
    }
    SEAM(0);
    if (IN(1)) { PH_IDS
        pg8::Gemm g{HN, W_GLA_IN, M, GLA_IN_NP, 4096}; pg8::StaticOrder S; S.init(M, GLA_IN_NP, G, blk);
        pg8::EpiGlaIn E{(bf16_t*)(ws + WS_GQ), (bf16_t*)(ws + WS_GK), (bf16_t*)(ws + WS_GV), (bf16_t*)(ws + WS_GR), (float*)(ws + WS_GA1)};
        pg8::gemm_phase<pg8::EpiGlaIn, pg8::StaticOrder, true, true>(lds, g, S, E, tid);
    }
    SEAM(1);
    if (IN(2)) { PH_IDS
        for (int u = blk; u < 2048; u += G)
            gla_pre_unit(u >> 3, u & 7, (bf16_t*)(ws + WS_GQ), (bf16_t*)(ws + WS_GK), (const float*)(ws + WS_GA1), args.in[5], args.in[6], (bf16_t*)(ws + WS_GKT), (float*)(ws + WS_GEBL), (LAS float*)lds, tid);
    }
    SEAM(2);
    if (IN(3)) { PH_IDS
        if (G >= 256) {
            if (blk < 128) gla_scan_unit(blk >> 6, (blk >> 3) & 7, blk & 7, (const bf16_t*)(ws + WS_GQ), (const bf16_t*)(ws + WS_GK), (const bf16_t*)(ws + WS_GKT), (const bf16_t*)(ws + WS_GV), (const float*)(ws + WS_GEBL), (bf16_t*)(ws + WS_GORAW), lds, tid);
            else { LAS float* scr = (LAS float*)(lds + wave * 16640); const int cgw = (blk - 128) * NWAVES + wave, CNGW = (G - 128) * NWAVES;
        convert_matrix(args.in[8], 1, 4096, 4096, 4096, W_GLA_O, scr, cgw, CNGW, lane);
        convert_matrix(args.in[9], 1, 4096, DSA_IN_N, DSA_IN_NP, W_DSA_IN, scr, cgw, CNGW, lane);
        convert_matrix(args.in[12], 1, 1024, 16384, 16384, W_QUP, scr, cgw, CNGW, lane);
        convert_matrix(args.in[13], 64, 128, 512, 512, W_UK, scr, cgw, CNGW, lane);
        convert_matrix<false, true>(args.in[14], 64, 512, 128, 128, W_UV, scr, cgw, CNGW, lane, WUV_SC);
        convert_matrix<false, true>(args.in[15], 1, 8192, 4096, 4096, W_DSA_O, scr, cgw, CNGW, lane, WO_SC);
        convert_matrix<true>(args.in[16], 1, 4096, DFF2, DFF2, W_UP, scr, cgw, CNGW, lane);
        convert_matrix<true, true>(args.in[16] + (size_t)4096 * DFF2, 1, 4096, DFF2, DFF2, W_UP + (size_t)DFF2 * 4096, scr, cgw, CNGW, lane, WUP_SC);
        convert_matrix(args.in[19], 1, DFF, 4096, 4096, W_DN, scr, cgw, CNGW, lane);
        convert_matrix<false, true>(args.in[19] + (size_t)DFF * 4096, 1, DFF, 4096, 4096, W_DN + (size_t)4096 * DFF, scr, cgw, CNGW, lane, WDN_SC);
            }
        } else {
            for (int u = blk; u < 128; u += G)
                gla_scan_unit(u >> 6, (u >> 3) & 7, u & 7, (const bf16_t*)(ws + WS_GQ), (const bf16_t*)(ws + WS_GK), (const bf16_t*)(ws + WS_GKT), (const bf16_t*)(ws + WS_GV), (const float*)(ws + WS_GEBL), (bf16_t*)(ws + WS_GORAW), lds, tid);
            { LAS float* scr = (LAS float*)(lds + wave * 16640); const int cgw = gw, CNGW = NGW;
        convert_matrix(args.in[8], 1, 4096, 4096, 4096, W_GLA_O, scr, cgw, CNGW, lane);
        convert_matrix(args.in[9], 1, 4096, DSA_IN_N, DSA_IN_NP, W_DSA_IN, scr, cgw, CNGW, lane);
        convert_matrix(args.in[12], 1, 1024, 16384, 16384, W_QUP, scr, cgw, CNGW, lane);
        convert_matrix(args.in[13], 64, 128, 512, 512, W_UK, scr, cgw, CNGW, lane);
        convert_matrix<false, true>(args.in[14], 64, 512, 128, 128, W_UV, scr, cgw, CNGW, lane, WUV_SC);
        convert_matrix<false, true>(args.in[15], 1, 8192, 4096, 4096, W_DSA_O, scr, cgw, CNGW, lane, WO_SC);
        convert_matrix<true>(args.in[16], 1, 4096, DFF2, DFF2, W_UP, scr, cgw, CNGW, lane);
        convert_matrix<true, true>(args.in[16] + (size_t)4096 * DFF2, 1, 4096, DFF2, DFF2, W_UP + (size_t)DFF2 * 4096, scr, cgw, CNGW, lane, WUP_SC);
        convert_matrix(args.in[19], 1, DFF, 4096, 4096, W_DN, scr, cgw, CNGW, lane);
        convert_matrix<false, true>(args.in[19] + (size_t)DFF * 4096, 1, DFF, 4096, 4096, W_DN + (size_t)4096 * DFF, scr, cgw, CNGW, lane, WDN_SC);
            }
        }
    }
    SEAM(3);
    if (IN(4)) { PH_IDS gla_out_norm((const bf16_t*)(ws + WS_GORAW), (const bf16_t*)(ws + WS_GR), args.in[7], (bf16_t*)(ws + WS_GOG), gw, NGW, lane); }
    SEAM(4);
    if (IN(5)) { PH_IDS
        pg8::Gemm g{(const bf16_t*)(ws + WS_GOG), W_GLA_O, M, 4096, 4096}; pg8::StaticOrder S; S.init(M, 4096, G, blk);
        pg8::EpiResBf16<true> E{x, H, 4096};
        pg8::gemm_phase<pg8::EpiResBf16<true>, pg8::StaticOrder, true, true>(lds, g, S, E, tid);
    }
    SEAM(5);
    if (IN(6)) { PH_IDS rmsnorm_rows_from_bf16<false>(H, g_ffn, HN, gw, NGW, lane); }
    SEAM(6);
    if (IN(7)) { PH_IDS
        pg8::Gemm g{HN, W_UP, M, DFF2, 4096}; pg8::StaticOrder S; S.init(M, DFF2, G, blk);
        pg8::EpiConvAct<false> E{(bf16_t*)(ws + WS_ACT), (bf16_t*)(ws + WS_U), args.in[17], args.in[18]};
        pg8::gemm_phase<pg8::EpiConvAct<false>, pg8::StaticOrder, true, true>(lds, g, S, E, tid);
    }
    SEAM(7);
    if (IN(8)) { PH_IDS conv_fixup<false>((const bf16_t*)(ws + WS_U), args.in[17], args.in[18], (bf16_t*)(ws + WS_ACT), blk * NTHR + tid, G * NTHR); }
    SEAM(8);
    if (IN(9)) { PH_IDS
        pg8::Gemm g{(const bf16_t*)(ws + WS_ACT), W_DN, M, 4096, DFF, 0}; pg8::StaticOrder S; S.init(M, 4096, G, blk);
        pg8::EpiResBf16<false> E{H, H, 4096};
        pg8::gemm_phase<pg8::EpiResBf16<false>, pg8::StaticOrder, true, true>(lds, g, S, E, tid);
    }
    SEAM(9);
    if (IN(10)) { PH_IDS rmsnorm_rows_from_bf16<false>(H, g_mix + D, HN, gw, NGW, lane); }
    SEAM(10);
    if (IN(11)) { PH_IDS
        pg8::Gemm g{HN, W_DSA_IN, M, DSA_IN_NP, 4096}; pg8::StaticOrder S; S.init(M, DSA_IN_NP, G, blk);
        pg8::EpiF32 E{(float*)(ws + WS_Z), DSA_IN_NP};
        pg8::gemm_phase<pg8::EpiF32, pg8::StaticOrder, true, true>(lds, g, S, E, tid);
    }
    SEAM(11);
    if (IN(12)) { PH_IDS dsa_norm((const float*)(ws + WS_Z), args.in[10], args.in[11], (bf16_t*)(ws + WS_CQN), (bf16_t*)(ws + WS_CKV), (bf16_t*)(ws + WS_KIDX), (float*)(ws + WS_WIDX), gw, NGW, lane); }
    SEAM(12);
    if (IN(13)) { PH_IDS
        pg8::Gemm g{(const bf16_t*)(ws + WS_CQN), W_QUP, M, 16384, 1024}; pg8::StaticOrder S; S.init(M, 16384, G, blk);
        pg8::EpiBf16Split E{(bf16_t*)(ws + WS_QATT), 8192, 8192, (size_t)(WS_QIDX - WS_QATT) / 2};
        pg8::gemm_phase<pg8::EpiBf16Split, pg8::StaticOrder, true, true>(lds, g, S, E, tid);
    }
    SEAM(13);
    if (IN(14)) { PH_IDS
        for (int i = 0; i * G < 1024; ++i) { const int u = i * G + ((i & 1) ? (G - 1 - blk) : blk); if (u < 1024) indexer_group(u, (const bf16_t*)(ws + WS_QIDX), (const bf16_t*)(ws + WS_KIDX), (const float*)(ws + WS_WIDX), (float*)(ws + WS_SC), lds, tid); }
        asm volatile("s_waitcnt vmcnt(0)" ::: "memory");
        for (int i = 0; i * G < 1024; ++i) { const int u = i * G + ((i & 1) ? (G - 1 - blk) : blk); if (u < 1024) {
#pragma unroll 1
            for (int tk = 0; tk < 2; ++tk) topk_token(16 * u + 2 * wave + tk, (const float*)(ws + WS_SC), (int*)(ws + WS_SEL), lane); } }
    }
    SEAM(15);
    if (IN(16)) { PH_IDS
        pg8::Gemm g{(const bf16_t*)(ws + WS_QATT), W_UK, M, 32768, 128, 8192}; pg8::StaticOrder S; S.init(M, 32768, G, blk);
        pg8::EpiBf16Split E{(bf16_t*)(ws + WS_QLAT), 32768, 0, 0};
        pg8::gemm_phase<pg8::EpiBf16Split, pg8::StaticOrder, true, true, 1>(lds, g, S, E, tid);
    }
    SEAM(16);
    if (IN(17)) { PH_IDS
        attn_stream(blk, G, (bf16_t*)(ws + WS_QLAT), (const bf16_t*)(ws + WS_CKV), (const int*)(ws + WS_SEL), lds, tid);
    }
    SEAM(17);
    if (IN(18)) { PH_IDS
        pg8::Gemm g{(const bf16_t*)(ws + WS_QLAT), W_UV, M, 8192, 256, 32768}; pg8::StaticOrder S; S.init(128 * 256, 32 * 256, G, blk);
        pg8::EpiDiag<true> E{(bf16_t*)(ws + WS_QATT), 8192, DSO_SC / (OL_SC * WUV_SC)};
        pg8::gemm_phase<pg8::EpiDiag<true>, pg8::StaticOrder, true, true, 2, true>(lds, g, S, E, tid);
    }
    SEAM(18);
    if (IN(19)) { PH_IDS
        pg8::Gemm g{(const bf16_t*)(ws + WS_QATT), W_DSA_O, M, 4096, 4096}; pg8::StaticOrder S; S.init(M, 4096, G, blk);
        pg8::EpiResBf16<false, DSAO_SH> E{H, H, 4096};
        pg8::gemm_phase<pg8::EpiResBf16<false, DSAO_SH>, pg8::StaticOrder, true, true, 0, true>(lds, g, S, E, tid);
    }
    SEAM(19);
    if (IN(20)) { PH_IDS rmsnorm_rows_from_bf16<2>(H, g_ffn + D, HN, gw, NGW, lane); }
    SEAM(20);
    if (IN(21)) { PH_IDS
        pg8::Gemm g{HN, W_UP + (size_t)DFF2 * 4096, M, DFF2, 2048}; pg8::StaticOrder S; S.init(M, DFF2, G, blk);
        pg8::EpiConvAct<true, UP_SH> E{(bf16_t*)(ws + WS_ACT), (bf16_t*)(ws + WS_U), args.in[17] + (size_t)3 * DFF2, args.in[18] + DFF2};
        pg8::gemm_phase<pg8::EpiConvAct<true, UP_SH>, pg8::StaticOrder, true, true, 0, true>(lds, g, S, E, tid);
    }
    SEAM(21);
    if (IN(22)) { PH_IDS conv_fixup<true>((const bf16_t*)(ws + WS_U), args.in[17] + (size_t)3 * DFF2, args.in[18] + DFF2, (bf16_t*)(ws + WS_ACT), blk * NTHR + tid, G * NTHR); }
    SEAM(22);
    if (IN(23)) { PH_IDS
        pg8::Gemm g{(const bf16_t*)(ws + WS_ACT), W_DN + (size_t)4096 * DFF, M, 4096, DFF / 2, 0}; pg8::StaticOrder S; S.init(M, 4096, G, blk);
        pg8::EpiResBf16<false, DN_SH> E{H, H, 4096};
        pg8::gemm_phase<pg8::EpiResBf16<false, DN_SH>, pg8::StaticOrder, true, true, 0, true>(lds, g, S, E, tid);
    }
    SEAM(23);
    if (IN(24)) { PH_IDS rmsnorm_rows_from_bf16<true>(H, g_final, args.out, gw, NGW, lane); }
#undef IN
#undef SEAM
}

extern "C" void kernel_launch(void* const* d_in, const int* in_sizes, int n_in, void* d_out, int out_size, void* d_ws, size_t ws_size, hipStream_t stream) {
    static int grid = 0;
    if (grid == 0) {
        if (n_in != 20 || in_sizes[0] != M * D || out_size != M * D || ws_size < WS_END) { fprintf(stderr, "kernel_launch: unexpected shapes / workspace (n_in %d, ws %zu < %zu); nothing launched\n", n_in, ws_size, (size_t)WS_END); grid = -1; return; }
        int dev = 0, cus = 0, per_cu = 0;
        if (hipGetDevice(&dev) != hipSuccess || hipDeviceGetAttribute(&cus, hipDeviceAttributeMultiprocessorCount, dev) != hipSuccess) { grid = -1; return; }
        if (hipFuncSetAttribute((const void*)fwd, hipFuncAttributeMaxDynamicSharedMemorySize, LDS_BYTES) != hipSuccess) { fprintf(stderr, "kernel_launch: hipFuncSetAttribute failed\n"); grid = -1; return; }
        if (hipOccupancyMaxActiveBlocksPerMultiprocessor(&per_cu, (const void*)fwd, NTHR, LDS_BYTES) != hipSuccess || per_cu < 1) { fprintf(stderr, "kernel_launch: occupancy query says %d blocks per CU\n", per_cu); }
        (void)hipGetLastError();
        grid = cus;
    }
    if (grid < 0) return;
    if (hipMemsetAsync((char*)d_ws + WS_CTL, 0, CTL_ZERO_BYTES, stream) != hipSuccess) return;
    Args a{};
    for (int i = 0; i < 20; ++i) a.in[i] = (const float*)d_in[i];
    a.out = (float*)d_out; a.ws = (unsigned char*)d_ws;
#if MK_ONE_LAUNCH
    a.ph_lo = 0; a.ph_hi = NPH;
    hipLaunchKernelGGL(fwd, dim3(grid), dim3(NTHR), LDS_BYTES, stream, a);
#else
    for (int p = 0; p < NPH; ++p) { a.ph_lo = p; a.ph_hi = p + 1; hipLaunchKernelGGL(fwd, dim3(grid), dim3(NTHR), LDS_BYTES, stream, a); }
#endif
}
```

```cpp
#include <hip/hip_runtime.h>
#include <stdint.h>
#include <stdio.h>

#define GAS __attribute__((address_space(1)))
#define LAS __attribute__((address_space(3)))
typedef unsigned short bf16_t;
typedef short bf16x8 __attribute__((ext_vector_type(8)));
typedef short s16x4 __attribute__((ext_vector_type(4)));
typedef float f32x4 __attribute__((ext_vector_type(4)));
typedef unsigned u32x4 __attribute__((ext_vector_type(4)));
typedef unsigned u32x2 __attribute__((ext_vector_type(2)));

namespace pg8 {
#define PG8_LAS __attribute__((address_space(3)))
typedef unsigned short bf16_t;
typedef short bf16x8 __attribute__((ext_vector_type(8)));
typedef float f32x4 __attribute__((ext_vector_type(4)));
typedef unsigned u32x4 __attribute__((ext_vector_type(4)));
constexpr int BM = 256, BK = 64, HALF = 128, HTB = HALF * BK * 2  , STAGE_BYTES = 8 * HTB, NXCD = 8, WGM = 8;

__host__ __device__ __forceinline__ int lds_byte(int r, int c) { const int st = (r >> 4) * 2 + (c >> 5), rr = r & 15, cc = c & 31, ob = rr * 64 + cc * 2; return st * 1024 + (ob ^ (((ob >> 9) & 1) << 5)); }
__host__ __device__ __forceinline__ void stage_rc(int b, int& R, int& C) { const int st = b / 1024, sb = b % 1024, swz = sb ^ (((sb >> 9) & 1) << 5); R = (st >> 1) * 16 + swz / 64; C = (st & 1) * 32 + (swz % 64) / 2; }
__host__ __device__ __forceinline__ int perm32(int rho) { const int n = rho >> 4, i = rho & 15; return 8 * (i >> 2) + 4 * n + (i & 3); }

struct Unit { int pm, pn; };
typedef int v4i_t __attribute__((ext_vector_type(4))); typedef int v8i_t __attribute__((ext_vector_type(8)));
struct Gemm { const bf16_t* A; const bf16_t* Bt; int M, N, K; int lda; };

struct StaticOrder {
    int nM, nN, nwg, G, c;
    __host__ __device__ void init(int M, int N, int G_, int c_) { nM = M / BM; nN = N / BM; nwg = nM * nN; G = G_; c = c_; }
    __host__ __device__ bool next(int i, Unit& u) const {
        const long L = (long)i * G + c; if (L >= nwg) return false;
        int wgid = (int)L; { const int q = nwg / NXCD, r = nwg % NXCD, xcd = wgid % NXCD, off = wgid / NXCD; wgid = (xcd < r ? xcd * (q + 1) : r * (q + 1) + (xcd - r) * q) + off; }
        const int nig = WGM * nN, gid = wgid / nig, fm = gid * WGM, gsz = (nM - fm) < WGM ? (nM - fm) : WGM;
        u.pm = fm + ((wgid % nig) % gsz); u.pn = (wgid % nig) / gsz; return true;
    }
    __device__ __forceinline__ void a_ready(const Unit&) const {}
    __device__ __forceinline__ void done(const Unit&) const {}
};
__device__ __forceinline__ unsigned cvt_pk_bf16(float lo, float hi) { unsigned r; asm volatile("v_cvt_pk_bf16_f32 %0, %1, %2" : "=v"(r) : "v"(lo), "v"(hi)); return r; }

struct EpiBf16Split {
    static constexpr bool PERM = true, AFTER_DRAIN = false, LDS_PRE = false;
    bf16_t* O; int ldc; int split_cols; size_t split_stride;
    __device__ __forceinline__ void operator()(const f32x4 (&acc)[2][2][4][2], const Unit& u, int wr, int wc, int fr, int fq) const {
        const int row0 = u.pm * BM + wr * 64 + fr; int colt = u.pn * BM; bf16_t* base = O;
        if (split_cols) { const int t = colt / split_cols; base += (size_t)t * split_stride; colt -= t * split_cols; }
        const int col0 = colt + wc * 32 + 8 * fq;
#pragma unroll
        for (int ai = 0; ai < 2; ++ai)
#pragma unroll
            for (int m = 0; m < 4; ++m) { bf16_t* rowp = base + (size_t)(row0 + ai * HALF + m * 16) * ldc + col0;
#pragma unroll
                for (int bj = 0; bj < 2; ++bj) { const f32x4 v0 = acc[ai][bj][m][0], v1 = acc[ai][bj][m][1];
                    u32x4 w; w.x = cvt_pk_bf16(v0[0], v0[1]); w.y = cvt_pk_bf16(v0[2], v0[3]); w.z = cvt_pk_bf16(v1[0], v1[1]); w.w = cvt_pk_bf16(v1[2], v1[3]);
                    *(u32x4*)(rowp + bj * HALF) = w; } }
    }
};
struct EpiF32 {
    static constexpr bool PERM = false, AFTER_DRAIN = false, LDS_PRE = false;
    float* C; int ldc;
    __device__ __forceinline__ void operator()(const f32x4 (&acc)[2][2][4][2], const Unit& u, int wr, int wc, int fr, int fq) const {
        const int row0 = u.pm * BM + wr * 64 + fr, col0 = u.pn * BM + wc * 32 + 4 * fq;
#pragma unroll
        for (int ai = 0; ai < 2; ++ai)
#pragma unroll
            for (int m = 0; m < 4; ++m) { float* rowp = C + (size_t)(row0 + ai * HALF + m * 16) * ldc + col0;
#pragma unroll
                for (int bj = 0; bj < 2; ++bj)
#pragma unroll
                    for (int n = 0; n < 2; ++n) *(f32x4*)(rowp + bj * HALF + n * 16) = acc[ai][bj][m][n]; }
    }
};
struct EpiResF32 {
    static constexpr bool PERM = false, AFTER_DRAIN = false, LDS_PRE = false;
    const float* R; float* C; int ldc;
    __device__ __forceinline__ void operator()(const f32x4 (&acc)[2][2][4][2], const Unit& u, int wr, int wc, int fr, int fq) const {
        const int row0 = u.pm * BM + wr * 64 + fr, col0 = u.pn * BM + wc * 32 + 4 * fq;
#pragma unroll
        for (int ai = 0; ai < 2; ++ai)
#pragma unroll
            for (int m = 0; m < 4; ++m) { const size_t off = (size_t)(row0 + ai * HALF + m * 16) * ldc + col0;
                f32x4 rv[2][2];
#pragma unroll
                for (int bj = 0; bj < 2; ++bj)
#pragma unroll
                    for (int n = 0; n < 2; ++n) rv[bj][n] = *(const f32x4*)(R + off + bj * HALF + n * 16);
#pragma unroll
                for (int bj = 0; bj < 2; ++bj)
#pragma unroll
                    for (int n = 0; n < 2; ++n) *(f32x4*)(C + off + bj * HALF + n * 16) = rv[bj][n] + acc[ai][bj][m][n];
                if (m & 1) asm volatile("" ::: "memory"); }
    }
};
template <bool RF32, int SH = 0> struct EpiResBf16 {
    static constexpr bool PERM = true, AFTER_DRAIN = false, LDS_PRE = false;
    const void* R; bf16_t* HB; int ldc;
    __device__ __forceinline__ void operator()(const f32x4 (&acc)[2][2][4][2], const Unit& u, int wr, int wc, int fr, int fq) const {
        const int row0 = u.pm * BM + wr * 64 + fr, col0 = u.pn * BM + wc * 32 + 8 * fq;
        if constexpr (!RF32) {
            u32x4 rw[2][4][2];
#pragma unroll
            for (int ai = 0; ai < 2; ++ai)
#pragma unroll
                for (int m = 0; m < 4; ++m)
#pragma unroll
                    for (int bj = 0; bj < 2; ++bj) rw[ai][m][bj] = *(const u32x4*)((const bf16_t*)R + (size_t)(row0 + ai * HALF + m * 16) * ldc + col0 + bj * HALF);
            asm volatile("" ::: "memory");
#pragma unroll
            for (int ai = 0; ai < 2; ++ai)
#pragma unroll
                for (int m = 0; m < 4; ++m) { const size_t off = (size_t)(row0 + ai * HALF + m * 16) * ldc + col0;
#pragma unroll
                    for (int bj = 0; bj < 2; ++bj) { const u32x4 w0 = rw[ai][m][bj]; constexpr float sc = 1.0f / (float)(1 << SH);
                        const f32x4 r0 = (f32x4){__builtin_bit_cast(float, w0.x << 16), __builtin_bit_cast(float, w0.x & 0xffff0000u), __builtin_bit_cast(float, w0.y << 16), __builtin_bit_cast(float, w0.y & 0xffff0000u)};
                        const f32x4 r1 = (f32x4){__builtin_bit_cast(float, w0.z << 16), __builtin_bit_cast(float, w0.z & 0xffff0000u), __builtin_bit_cast(float, w0.w << 16), __builtin_bit_cast(float, w0.w & 0xffff0000u)};
                        const f32x4 v0 = SH ? r0 + acc[ai][bj][m][0] * sc : r0 + acc[ai][bj][m][0], v1 = SH ? r1 + acc[ai][bj][m][1] * sc : r1 + acc[ai][bj][m][1];
                        u32x4 w; w.x = cvt_pk_bf16(v0[0], v0[1]); w.y = cvt_pk_bf16(v0[2], v0[3]); w.z = cvt_pk_bf16(v1[0], v1[1]); w.w = cvt_pk_bf16(v1[2], v1[3]);
                        *(u32x4*)(HB + off + bj * HALF) = w; } }
        } else {
#pragma unroll
        for (int ai = 0; ai < 2; ++ai)
#pragma unroll
            for (int m = 0; m < 4; ++m) { const size_t off = (size_t)(row0 + ai * HALF + m * 16) * ldc + col0;
                f32x4 r0[2], r1[2];
#pragma unroll
                for (int bj = 0; bj < 2; ++bj) { r0[bj] = *(const f32x4*)((const float*)R + off + bj * HALF); r1[bj] = *(const f32x4*)((const float*)R + off + bj * HALF + 4); }
#pragma unroll
                for (int bj = 0; bj < 2; ++bj) { constexpr float sc = 1.0f / (float)(1 << SH); const f32x4 v0 = SH ? r0[bj] + acc[ai][bj][m][0] * sc : r0[bj] + acc[ai][bj][m][0], v1 = SH ? r1[bj] + acc[ai][bj][m][1] * sc : r1[bj] + acc[ai][bj][m][1];
                    u32x4 w; w.x = cvt_pk_bf16(v0[0], v0[1]); w.y = cvt_pk_bf16(v0[2], v0[3]); w.z = cvt_pk_bf16(v1[0], v1[1]); w.w = cvt_pk_bf16(v1[2], v1[3]);
                    *(u32x4*)(HB + off + bj * HALF) = w; }
                if (m & 1) asm volatile("" ::: "memory"); }
        }
    }
};
struct EpiGlaIn {
    static constexpr bool PERM = true, AFTER_DRAIN = false, LDS_PRE = false;
    bf16_t *Q, *K, *V, *Rg; float* A1;
    __device__ __forceinline__ void operator()(const f32x4 (&acc)[2][2][4][2], const Unit& u, int wr, int wc, int fr, int fq) const {
        const int row0 = u.pm * BM + wr * 64 + fr; const int colt = u.pn * BM;
        if (u.pn < 48) {
            bf16_t* base; int ldc, c0;
            if (colt < 2048) { base = Q; ldc = 2048; c0 = colt; }
            else if (colt < 4096) { base = K; ldc = 2048; c0 = colt - 2048; }
            else if (colt < 8192) { base = V; ldc = 4096; c0 = colt - 4096; }
            else { base = Rg; ldc = 4096; c0 = colt - 8192; }
            const int col0 = c0 + wc * 32 + 8 * fq;
#pragma unroll
            for (int ai = 0; ai < 2; ++ai)
#pragma unroll
                for (int m = 0; m < 4; ++m) { bf16_t* rowp = base + (size_t)(row0 + ai * HALF + m * 16) * ldc + col0;
#pragma unroll
                    for (int bj = 0; bj < 2; ++bj) { const f32x4 v0 = acc[ai][bj][m][0], v1 = acc[ai][bj][m][1];
                        u32x4 w; w.x = cvt_pk_bf16(v0[0], v0[1]); w.y = cvt_pk_bf16(v0[2], v0[3]); w.z = cvt_pk_bf16(v1[0], v1[1]); w.w = cvt_pk_bf16(v1[2], v1[3]);
                        *(u32x4*)(rowp + bj * HALF) = w; } }
        } else if (wc == 0 && fq < 2) {
#pragma unroll
            for (int ai = 0; ai < 2; ++ai)
#pragma unroll
                for (int m = 0; m < 4; ++m) { float* p = A1 + (size_t)(row0 + ai * HALF + m * 16) * 16 + 8 * fq;
                    *(f32x4*)p = acc[ai][0][m][0]; *(f32x4*)(p + 4) = acc[ai][0][m][1]; }
        }
    }
};

__device__ __forceinline__ unsigned pack4_fp8_e(float a, float b, float c2, float d) {
    a = __builtin_amdgcn_fmed3f(a, -448.f, 448.f); b = __builtin_amdgcn_fmed3f(b, -448.f, 448.f); c2 = __builtin_amdgcn_fmed3f(c2, -448.f, 448.f); d = __builtin_amdgcn_fmed3f(d, -448.f, 448.f);
    unsigned p; asm volatile("v_cvt_pk_fp8_f32 %0, %1, %2" : "=v"(p) : "v"(a), "v"(b)); asm volatile("v_cvt_pk_fp8_f32 %0, %1, %2 op_sel:[0,0,1]" : "+v"(p) : "v"(c2), "v"(d)); return p; }
template <bool O8 = false> struct EpiDiag {
    static constexpr bool PERM = true, AFTER_DRAIN = false, LDS_PRE = false;
    bf16_t* O; int ldc; float osc;
    __device__ __forceinline__ void operator()(const f32x4 (&acc)[2][2][4][2], const Unit& u, int wr, int wc, int fr, int fq) const {
        const int row0 = u.pm * HALF + wr * 64 + fr, col0 = u.pn * BM + wc * 32 + 8 * fq;
#pragma unroll
        for (int ai = 0; ai < 2; ++ai)
#pragma unroll
            for (int m = 0; m < 4; ++m) { bf16_t* rowp = O + (size_t)(row0 + m * 16) * ldc + col0 + ai * HALF;
                const f32x4 v0 = acc[ai][ai][m][0], v1 = acc[ai][ai][m][1];
                if (O8) { u32x2 w; w.x = pack4_fp8_e(v0[0] * osc, v0[1] * osc, v0[2] * osc, v0[3] * osc); w.y = pack4_fp8_e(v1[0] * osc, v1[1] * osc, v1[2] * osc, v1[3] * osc);
                    *(u32x2*)((unsigned char*)O + (size_t)(row0 + m * 16) * ldc + col0 + ai * HALF) = w; }
                else { u32x4 w; w.x = cvt_pk_bf16(v0[0], v0[1]); w.y = cvt_pk_bf16(v0[2], v0[3]); w.z = cvt_pk_bf16(v1[0], v1[1]); w.w = cvt_pk_bf16(v1[2], v1[3]);
                    *(u32x4*)rowp = w; } }
    }
};

__device__ __forceinline__ float dpp_ror1f(float x) { return __builtin_bit_cast(float, __builtin_amdgcn_mov_dpp(__builtin_bit_cast(int, x), 0x121, 0xf, 0xf, false)); }
__device__ __forceinline__ float dpp_ror2f(float x) { return __builtin_bit_cast(float, __builtin_amdgcn_mov_dpp(__builtin_bit_cast(int, x), 0x122, 0xf, 0xf, false)); }
__device__ __forceinline__ f32x4 dpp_ror1(f32x4 v) { return (f32x4){dpp_ror1f(v.x), dpp_ror1f(v.y), dpp_ror1f(v.z), dpp_ror1f(v.w)}; }
__device__ __forceinline__ f32x4 dpp_ror2(f32x4 v) { return (f32x4){dpp_ror2f(v.x), dpp_ror2f(v.y), dpp_ror2f(v.z), dpp_ror2f(v.w)}; }
struct EpiQLat8 {
    static constexpr bool PERM = true, AFTER_DRAIN = false, LDS_PRE = false;
    unsigned char* O; float sc;
    __device__ __forceinline__ void operator()(const f32x4 (&acc)[2][2][4][2], const Unit& u, int wr, int wc, int fr, int fq) const {
        const int row0 = u.pm * BM + wr * 64 + fr, col0 = u.pn * BM + wc * 32 + 8 * fq;
#pragma unroll
        for (int ai = 0; ai < 2; ++ai)
#pragma unroll
            for (int m = 0; m < 4; ++m) { unsigned char* rowp = O + (size_t)(row0 + ai * HALF + m * 16) * 65536 + col0;
#pragma unroll
                for (int bj = 0; bj < 2; ++bj) { const f32x4 v0 = acc[ai][bj][m][0] * sc, v1 = acc[ai][bj][m][1] * sc;
                    u32x2 w; w.x = pack4_fp8_e(v0[0], v0[1], v0[2], v0[3]); w.y = pack4_fp8_e(v1[0], v1[1], v1[2], v1[3]);
                    *(u32x2*)(rowp + bj * HALF) = w; } }
    }
};
template <bool F8OUT = true, int ASH = 0> struct EpiConvAct {
    static constexpr bool PERM = true, AFTER_DRAIN = false, LDS_PRE = true;
    static constexpr int CONV_LDS = STAGE_BYTES;
    bf16_t* ACT; bf16_t* UH; const float* cw; const float* cb;
    __device__ __forceinline__ void prefetch(const Unit& u, PG8_LAS unsigned char* lds, int wid, int lane, int buf) const {
        constexpr int DFFc = 11008, DFF2c = 22016;
        const int arr = wid >> 1, isup = wid & 1;
        const float* src = (arr < 3 ? cw + (size_t)arr * DFF2c : cb) + (isup ? DFFc : 0) + u.pn * HALF;
        PG8_LAS unsigned char* dst = lds + CONV_LDS + buf * 4096 + wid * 512;
        __builtin_amdgcn_global_load_lds((const unsigned*)(src + lane), (PG8_LAS unsigned*)dst, 4, 0, 0);
        __builtin_amdgcn_global_load_lds((const unsigned*)(src + 64 + lane), (PG8_LAS unsigned*)(dst + 256), 4, 0, 0);
    }
    __device__ __forceinline__ void operator()(const f32x4 (&acc)[2][2][4][2], const Unit& u, int wr, int wc, int fr, int fq, const PG8_LAS unsigned char* lds, int buf) const {
        constexpr int DFFc = 11008, DFF2c = 22016;
        const PG8_LAS unsigned char* cl = lds + CONV_LDS + buf * 4096;
        const int lc = wc * 32 + 8 * fq, gc = u.pn * HALF + lc, run0 = u.pm * BM + wr * 64;
        unsigned pk[2][4][2];
#pragma unroll
        for (int n = 0; n < 2; ++n) {
            const int cg = gc + 4 * n, cu = DFFc + gc + 4 * n;
            const int lo4 = (lc + 4 * n) * 4; (void)cg; (void)cu;
#define PG8_CL(s) (*(const PG8_LAS f32x4*)(cl + (s) * 512 + lo4))
            constexpr float ASC = 1.0f / (float)(1 << ASH), CG = -1.4426950408889634f, CU = (F8OUT ? 4.0f : 1.0f) / CG, TG = CG * ASC, TU = CU * ASC;
            const f32x4 wg0 = PG8_CL(0) * TG, wg1 = PG8_CL(2) * TG, wg2 = PG8_CL(4) * TG, bg = PG8_CL(6) * CG;
            const f32x4 wu0 = PG8_CL(1) * TU, wu1 = PG8_CL(3) * TU, wu2 = PG8_CL(5) * TU, bu = PG8_CL(7) * CU;
#undef PG8_CL
#pragma unroll
            for (int ai = 0; ai < 2; ++ai) {
                f32x4 pg1 = (f32x4){0.f, 0.f, 0.f, 0.f}, pg2 = pg1, pu1 = pg1, pu2 = pg1;
                const int run = (run0 + ai * HALF) >> 6;
#pragma unroll
                for (int m = 0; m < 4; ++m) {
                    const f32x4 g = acc[ai][0][m][n], uu = acc[ai][1][m][n];
                    const f32x4 r1g = dpp_ror1(g), r2g = dpp_ror2(g), r1u = dpp_ror1(uu), r2u = dpp_ror2(uu);
                    const f32x4 s1g = fr == 0 ? pg1 : r1g, s2g = fr < 2 ? pg2 : r2g, s1u = fr == 0 ? pu1 : r1u, s2u = fr < 2 ? pu2 : r2u;
                    const f32x4 yg = bg + wg0 * s2g + wg1 * s1g + wg2 * g, yu = bu + wu0 * s2u + wu1 * s1u + wu2 * uu;
                    float a[4];
#pragma unroll
                    for (int i = 0; i < 4; ++i) a[i] = yg[i] * __builtin_amdgcn_rcpf(1.0f + __builtin_amdgcn_exp2f(yg[i])) * yu[i];
                    if constexpr (F8OUT) {
                        const unsigned q8 = pack4_fp8_e(a[0], a[1], a[2], a[3]);
                        if (n == 0) pk[ai][m][0] = q8;
                        else if (m > 0 || fr >= 2) { u32x2 w; w.x = pk[ai][m][0]; w.y = q8; *(u32x2*)((unsigned char*)ACT + (size_t)(run0 + ai * HALF + m * 16 + fr) * DFFc + gc) = w; }
                    } else {
                        const unsigned lo = cvt_pk_bf16(a[0], a[1]), hi = cvt_pk_bf16(a[2], a[3]);
                        if (n == 0) { pk[ai][m][0] = lo; pk[ai][m][1] = hi; }
                        else if (m > 0 || fr >= 2) { u32x4 w; w.x = pk[ai][m][0]; w.y = pk[ai][m][1]; w.z = lo; w.w = hi; *(u32x4*)(ACT + (size_t)(run0 + ai * HALF + m * 16 + fr) * DFFc + gc) = w; }
                    }
                    if ((m == 0 && fr < 2) || (m == 3 && fr >= 14)) {
                        const int slot = m == 0 ? 2 + fr : fr - 14;
                        bf16_t* hp = UH + ((size_t)run * 4 + slot) * DFF2c + u.pn * BM + lc + 4 * n;
                        const f32x4 gs = ASH ? g * ASC : g, us = ASH ? uu * ASC : uu;
                        u32x2 hg, hu; hg.x = cvt_pk_bf16(gs[0], gs[1]); hg.y = cvt_pk_bf16(gs[2], gs[3]); hu.x = cvt_pk_bf16(us[0], us[1]); hu.y = cvt_pk_bf16(us[2], us[3]);
                        *(u32x2*)hp = hg; *(u32x2*)(hp + HALF) = hu; }
                    pg1 = r1g; pg2 = r2g; pu1 = r1u; pu2 = r2u;
                }
            }
        }
    }
};

template <class Epi, class Sched, bool ALIGN_EPI = false, bool SP2 = false, int MODE = 0, bool F8 = false>
__device__ __forceinline__ void gemm_phase(PG8_LAS unsigned char* lds, const Gemm g, const Sched& S, const Epi& E, const int tid_in) {
    const int tid = tid_in, wid = __builtin_amdgcn_readfirstlane(tid >> 6), lane = tid & 63, wr = wid >> 2, wc = wid & 3, fr = lane & 15, fq = lane >> 4;
    const int K = g.K, nt = K / BK;
    const int lda = MODE ? g.lda : K;
    unsigned voffA[2], voffB[2];
#pragma unroll
    for (int i = 0; i < 2; ++i) { int R, C; stage_rc(tid * 16 + i * 8192, R, C); const int Rb = Epi::PERM ? ((R & ~31) + perm32(R & 31)) : R;
        voffA[i] = (unsigned)(R * lda + C) * 2u; voffB[i] = (unsigned)(Rb * K + C) * 2u; }
    const size_t kstep = (size_t)(BK * 2);
    const size_t hstepB = (size_t)HALF * K * 2, tstepB = 2 * hstepB;
    const size_t hstepA = (MODE == 2) ? (size_t)(F8 ? 512 : 1024) : (size_t)HALF * lda * 2;
    const size_t tstepA = (MODE == 2) ? (size_t)HALF * lda * 2 : 2 * (size_t)HALF * lda * 2;
#define PG8_APTR(u) ((const char*)g.A + (size_t)(u).pm * tstepA + (MODE == 1 ? (size_t)((u).pn >> 1) * 256 : (MODE == 2 ? (size_t)(u).pn * (F8 ? 1024 : 2048) : (size_t)0)))
#define PG8_BPTR(u) ((const char*)g.Bt + (size_t)(u).pn * tstepB)
#define PG8_MMAX(ai, bj, At, Bt) do { if constexpr (MODE != 2) PG8_MMA(ai, bj, At, Bt); } while (0)
    const unsigned ldsw = (unsigned)wid * 1024u;
    const int aoff = lds_byte(wr * 64 + fr, fq * 8), boff = lds_byte(wc * 32 + fr, fq * 8);
#define PG8_SA(b, h) (((b) * 2 + (h)) * HTB)
#define PG8_SB(b, h) ((4 + (b) * 2 + (h)) * HTB)
#define PG8_STAGE(bufoff, gbase, voff) do { _Pragma("unroll") for (int _i = 0; _i < 2; ++_i) \
        __builtin_amdgcn_global_load_lds((const unsigned*)((const char*)(gbase) + (voff)[_i]), (PG8_LAS unsigned*)(lds + (bufoff) + ldsw + _i * 8192), 16, 0, 0); } while (0)
#define PG8_LDA(dst, b, h) do { _Pragma("unroll") for (int m = 0; m < 4; ++m) _Pragma("unroll") for (int k = 0; k < 2; ++k) dst[m][k] = *(const PG8_LAS bf16x8*)(lds + PG8_SA(b, h) + aoff + m * 2048 + k * 1024); } while (0)
#define PG8_LDB(dst, b, h) do { _Pragma("unroll") for (int n = 0; n < 2; ++n) _Pragma("unroll") for (int k = 0; k < 2; ++k) dst[n][k] = *(const PG8_LAS bf16x8*)(lds + PG8_SB(b, h) + boff + n * 2048 + k * 1024); } while (0)
#define PG8_MMA(ai, bj, At, Bt) do { __builtin_amdgcn_s_setprio(1); \
        if constexpr (F8) { _Pragma("unroll") for (int m = 0; m < 4; ++m) _Pragma("unroll") for (int n = 0; n < 2; ++n) { \
            const v8i_t b8 = __builtin_shufflevector(__builtin_bit_cast(v4i_t, Bt[n][0]), __builtin_bit_cast(v4i_t, Bt[n][1]), 0, 1, 2, 3, 4, 5, 6, 7); \
            const v8i_t a8 = __builtin_shufflevector(__builtin_bit_cast(v4i_t, At[m][0]), __builtin_bit_cast(v4i_t, At[m][1]), 0, 1, 2, 3, 4, 5, 6, 7); \
            asm("v_mfma_f32_16x16x128_f8f6f4 %0, %1, %2, %0" : "+v"(acc[ai][bj][m][n]) : "v"(b8), "v"(a8)); } } \
        else { _Pragma("unroll") for (int m = 0; m < 4; ++m) _Pragma("unroll") for (int n = 0; n < 2; ++n) _Pragma("unroll") for (int k = 0; k < 2; ++k) \
            acc[ai][bj][m][n] = __builtin_amdgcn_mfma_f32_16x16x32_bf16(Bt[n][k], At[m][k], acc[ai][bj][m][n], 0, 0, 0); } \
        __builtin_amdgcn_s_setprio(0); } while (0)
#define PG8_WAIT_V(n) asm volatile("s_waitcnt vmcnt(" #n ")" ::: "memory")
#define PG8_WAIT_L(n) asm volatile("s_waitcnt lgkmcnt(" #n ")" ::: "memory")
#define PG8_BAR __builtin_amdgcn_s_barrier()
#define PG8_SCHED __builtin_amdgcn_sched_barrier(0)
    Unit cur, nxt; int ui = 0;
    if (!S.next(0, cur)) return;
    f32x4 acc[2][2][4][2];
#pragma unroll
    for (int a = 0; a < 2; ++a)
#pragma unroll
        for (int b = 0; b < 2; ++b)
#pragma unroll
            for (int m = 0; m < 4; ++m)
#pragma unroll
                for (int n = 0; n < 2; ++n) acc[a][b][m][n] = (f32x4){0.f, 0.f, 0.f, 0.f};
    bf16x8 At[4][2], B0[2][2], B1[2][2];
    const char* cA = PG8_APTR(cur); const char* cB = PG8_BPTR(cur);
    S.a_ready(cur);
    if constexpr (Epi::LDS_PRE) E.prefetch(cur, lds, wid, lane, 0);
    if constexpr (SP2) {
        PG8_STAGE(PG8_SB(0, 0), cB, voffB); PG8_STAGE(PG8_SB(0, 1), cB + hstepB, voffB); PG8_STAGE(PG8_SA(0, 0), cA, voffA); PG8_STAGE(PG8_SA(0, 1), cA + hstepA, voffA);
        if (wr == 1) PG8_BAR;
        PG8_WAIT_V(2); PG8_BAR;
        PG8_STAGE(PG8_SB(1, 0), cB + kstep, voffB); PG8_STAGE(PG8_SA(1, 0), cA + kstep, voffA); PG8_STAGE(PG8_SB(1, 1), cB + hstepB + kstep, voffB);
        PG8_WAIT_V(6); PG8_BAR;
    } else {
        PG8_STAGE(PG8_SB(0, 0), cB, voffB); PG8_STAGE(PG8_SA(0, 0), cA, voffA); PG8_STAGE(PG8_SB(0, 1), cB + hstepB, voffB); PG8_STAGE(PG8_SA(0, 1), cA + hstepA, voffA);
        if (wr == 1) PG8_BAR;
        PG8_WAIT_V(4); PG8_BAR;
        PG8_STAGE(PG8_SB(1, 0), cB + kstep, voffB); PG8_STAGE(PG8_SA(1, 0), cA + kstep, voffA); PG8_STAGE(PG8_SB(1, 1), cB + hstepB + kstep, voffB);
        PG8_WAIT_V(6); PG8_BAR;
    }
    for (;;) {
        const bool has_next = S.next(ui + 1, nxt);
        const char* nA = has_next ? PG8_APTR(nxt) : cA; const char* nB = has_next ? PG8_BPTR(nxt) : cB;
        for (int t = 0; t < nt; t += 2) {
            const bool last = (t == nt - 2);
            const char* a1 = cA + (size_t)(t + 1) * kstep;
            const char* a2 = last ? nA : cA + (size_t)(t + 2) * kstep; const char* b2 = last ? nB : cB + (size_t)(t + 2) * kstep;
            const char* a3 = a2 + kstep; const char* b3 = b2 + kstep;
            if (last && has_next) S.a_ready(nxt);
            if constexpr (SP2) {
            PG8_LDB(B0, 0, 0); PG8_LDB(B1, 0, 1); PG8_SCHED; PG8_LDA(At, 0, 0); PG8_STAGE(PG8_SA(1, 1), a1 + hstepA, voffA);
            PG8_WAIT_V(8); PG8_WAIT_L(0); PG8_BAR; PG8_MMA(0, 0, At, B0); PG8_MMAX(0, 1, At, B1); PG8_BAR; PG8_SCHED;
            PG8_LDA(At, 0, 1); PG8_STAGE(PG8_SB(0, 0), b2, voffB); PG8_STAGE(PG8_SB(0, 1), b2 + hstepB, voffB); PG8_STAGE(PG8_SA(0, 0), a2, voffA);
            PG8_WAIT_V(8); PG8_WAIT_L(0); PG8_BAR; PG8_MMAX(1, 0, At, B0); PG8_MMA(1, 1, At, B1); PG8_BAR; PG8_SCHED;
            PG8_LDB(B0, 1, 0); PG8_LDB(B1, 1, 1); PG8_SCHED; PG8_LDA(At, 1, 0); PG8_STAGE(PG8_SA(0, 1), a2 + hstepA, voffA);
            PG8_WAIT_V(8); PG8_WAIT_L(0); PG8_BAR; PG8_MMA(0, 0, At, B0); PG8_MMAX(0, 1, At, B1); PG8_BAR; PG8_SCHED;
            PG8_LDA(At, 1, 1); PG8_STAGE(PG8_SB(1, 0), b3, voffB); PG8_STAGE(PG8_SB(1, 1), b3 + hstepB, voffB); PG8_STAGE(PG8_SA(1, 0), a3, voffA);
            PG8_WAIT_V(8); PG8_WAIT_L(0); PG8_BAR; PG8_MMAX(1, 0, At, B0); PG8_MMA(1, 1, At, B1); PG8_BAR; PG8_SCHED;
            } else {
            PG8_LDB(B0, 0, 0); PG8_SCHED; PG8_LDA(At, 0, 0); PG8_STAGE(PG8_SA(1, 1), a1 + hstepA, voffA);
            PG8_WAIT_L(8); PG8_BAR; PG8_WAIT_L(0); PG8_MMA(0, 0, At, B0); PG8_BAR; PG8_SCHED;
            PG8_LDB(B1, 0, 1); PG8_STAGE(PG8_SB(0, 0), b2, voffB);
            PG8_BAR; PG8_WAIT_L(0); PG8_MMAX(0, 1, At, B1); PG8_BAR;
            PG8_LDA(At, 0, 1); PG8_STAGE(PG8_SA(0, 0), a2, voffA);
            PG8_BAR; PG8_WAIT_L(0); PG8_MMAX(1, 0, At, B0); PG8_BAR; PG8_SCHED;
            PG8_STAGE(PG8_SB(0, 1), b2 + hstepB, voffB);
            PG8_WAIT_V(6); PG8_BAR; PG8_MMA(1, 1, At, B1); PG8_BAR;
            PG8_LDB(B0, 1, 0); PG8_SCHED; PG8_LDA(At, 1, 0); PG8_STAGE(PG8_SA(0, 1), a2 + hstepA, voffA);
            PG8_WAIT_L(8); PG8_BAR; PG8_WAIT_L(0); PG8_MMA(0, 0, At, B0); PG8_BAR; PG8_SCHED;
            PG8_LDB(B1, 1, 1); PG8_STAGE(PG8_SB(1, 0), b3, voffB);
            PG8_BAR; PG8_WAIT_L(0); PG8_MMAX(0, 1, At, B1); PG8_BAR;
            PG8_LDA(At, 1, 1); PG8_STAGE(PG8_SA(1, 0), a3, voffA);
            PG8_BAR; PG8_WAIT_L(0); PG8_MMAX(1, 0, At, B0); PG8_BAR; PG8_SCHED;
            PG8_STAGE(PG8_SB(1, 1), b3 + hstepB, voffB);
            PG8_WAIT_V(6); PG8_BAR; PG8_MMA(1, 1, At, B1); PG8_BAR;
            }
        }
        if constexpr (F8) asm volatile("s_nop 15\n\ts_nop 15" ::: "memory");
        if constexpr (ALIGN_EPI) { if (wr == 0) PG8_BAR; }
        if constexpr (Epi::LDS_PRE) { if (has_next) E.prefetch(nxt, lds, wid, lane, (ui + 1) & 1); E(acc, cur, wr, wc, fr, fq, lds, ui & 1); S.done(cur); }
        else if constexpr (!Epi::AFTER_DRAIN) { E(acc, cur, wr, wc, fr, fq); S.done(cur); }
        if (!has_next) break;
#pragma unroll
        for (int a = 0; a < 2; ++a)
#pragma unroll
            for (int b = 0; b < 2; ++b)
#pragma unroll
                for (int m = 0; m < 4; ++m)
#pragma unroll
                    for (int n = 0; n < 2; ++n) acc[a][b][m][n] = (f32x4){0.f, 0.f, 0.f, 0.f};
        cur = nxt; cA = nA; cB = nB; ++ui;
        if constexpr (ALIGN_EPI) { if (wr == 1) PG8_BAR; }
    }
    PG8_WAIT_V(0);
    if constexpr (!ALIGN_EPI) { if (wr == 0) PG8_BAR; }
    PG8_BAR;
    if constexpr (Epi::AFTER_DRAIN) { E.fused(acc, cur, wr, wc, fr, fq, lds, wid, lane); S.done(cur); }
#undef PG8_SA
#undef PG8_APTR
#undef PG8_BPTR
#undef PG8_MMAX
#undef PG8_SB
#undef PG8_STAGE
#undef PG8_LDA
#undef PG8_LDB
#undef PG8_MMA
#undef PG8_WAIT_V
#undef PG8_WAIT_L
#undef PG8_BAR
#undef PG8_SCHED
}
}

constexpr int NWAVES = 8, NTHR = NWAVES * 64;
constexpr int D = 4096, SEQ = 8192, M = 2 * SEQ;
constexpr int GLA_IN_N = 12304, GLA_IN_NP = 12544;
constexpr int DSA_IN_N = 1728, DSA_IN_NP = 1792;
constexpr int DFF = 11008, DFF2 = 22016;
constexpr float RMS_EPS = 1e-6f;
constexpr float ACT_SC = 4.0f, WDN_SC = 128.0f; constexpr int DN_SH = 9;
constexpr float HN8_SC = 16.0f, WUP_SC = 128.0f; constexpr int UP_SH = 11;
constexpr float DSO_SC = 32.0f, WO_SC = 128.0f; constexpr int DSAO_SH = 12;
constexpr float OL_SC = 64.0f, WUV_SC = 128.0f;
constexpr float QL_SC = 16.0f;

constexpr size_t MiB = 1u << 20;
constexpr size_t WS_CTL = 0, CTL_ZERO_BYTES = 64 * 1024;
constexpr size_t WS_W_GLA_IN = 1 * MiB;
constexpr size_t WS_W_GLA_O  = WS_W_GLA_IN + 98 * MiB;
constexpr size_t WS_W_DSA_IN = WS_W_GLA_O + 32 * MiB;
constexpr size_t WS_W_QUP    = WS_W_DSA_IN + 14 * MiB;
constexpr size_t WS_W_UK     = WS_W_QUP + 32 * MiB;
constexpr size_t WS_W_UV     = WS_W_UK + 8 * MiB;
constexpr size_t WS_W_DSA_O  = WS_W_UV + 8 * MiB;
constexpr size_t WS_W_UP     = WS_W_DSA_O + 64 * MiB;
constexpr size_t WS_W_DN     = WS_W_UP + 344 * MiB;
constexpr size_t WS_H        = WS_W_DN + 172 * MiB;
constexpr size_t WS_HN       = WS_H + 256 * MiB;
constexpr size_t WS_BIG      = WS_HN + 128 * MiB;
constexpr size_t WS_GQ   = WS_BIG;
constexpr size_t WS_GK   = WS_GQ + 64 * MiB;
constexpr size_t WS_GV   = WS_GK + 64 * MiB;
constexpr size_t WS_GR   = WS_GV + 128 * MiB;
constexpr size_t WS_GA1  = WS_GR + 128 * MiB;
constexpr size_t WS_GKT  = WS_GA1 + 1 * MiB;
constexpr size_t WS_GEBL = WS_GKT + 64 * MiB;
constexpr size_t WS_GORAW = WS_GEBL + 2 * MiB;
constexpr size_t WS_GOG  = WS_GORAW + 256 * MiB;
constexpr size_t WS_GLA_END = WS_GOG + 128 * MiB;
constexpr size_t WS_U    = WS_BIG;
constexpr size_t WS_ACT  = WS_U + 688 * MiB;
constexpr size_t WS_FFN_END = WS_ACT + 344 * MiB;
constexpr size_t WS_CKV  = WS_BIG;
constexpr size_t WS_KIDX = WS_CKV + 16 * MiB;
constexpr size_t WS_WIDX = WS_KIDX + 4 * MiB;
constexpr size_t WS_SEL  = WS_WIDX + 4 * MiB;
constexpr size_t WS_CQN  = WS_SEL + 16 * MiB;
constexpr size_t WS_QATT = WS_CQN + 32 * MiB;
constexpr size_t WS_X    = WS_QATT + 256 * MiB;
constexpr size_t WS_Z    = WS_X;
constexpr size_t WS_QIDX = WS_X + 128 * MiB;
constexpr size_t WS_SC   = WS_X + 384 * MiB;
constexpr size_t WS_QLAT = WS_X;
constexpr size_t WS_DSA_END = WS_X + 1024 * MiB;
constexpr size_t WS_END = WS_DSA_END > WS_FFN_END ? (WS_DSA_END > WS_GLA_END ? WS_DSA_END : WS_GLA_END) : (WS_FFN_END > WS_GLA_END ? WS_FFN_END : WS_GLA_END);
static_assert(WS_SC + 512 * MiB <= WS_DSA_END && WS_QIDX + 256 * MiB <= WS_SC && WS_Z + 112 * MiB <= WS_QIDX, "DSA map");
static_assert(WS_END <= (size_t)2752 * MiB, "workspace over the guaranteed size");

constexpr int CW_BAR = 4096;
constexpr int LDS_BYTES = 159744;
constexpr int MISC_OFF = 158720;

#define LDS_WAIT() asm volatile("s_waitcnt lgkmcnt(0)" ::: "memory")
#define VM_WAIT() asm volatile("s_waitcnt vmcnt(0)" ::: "memory")
__device__ __forceinline__ unsigned f2bf(float f) { unsigned u = __builtin_bit_cast(unsigned, f); return (u + 0x7fffu + ((u >> 16) & 1u)) >> 16; }
__device__ __forceinline__ unsigned pk2(float lo, float hi) { return f2bf(lo) | (f2bf(hi) << 16); }
__device__ __forceinline__ float bf2f(unsigned b) { return __builtin_bit_cast(float, b << 16); }
__device__ __forceinline__ float bflo(unsigned w) { return __builtin_bit_cast(float, w << 16); }
__device__ __forceinline__ float bfhi(unsigned w) { return __builtin_bit_cast(float, w & 0xffff0000u); }
__device__ __forceinline__ float wave_sum(float v) {
#pragma unroll
    for (int o = 1; o < 64; o <<= 1) v += __shfl_xor(v, o);
    return v;
}
__device__ __forceinline__ float wave_max(float v) {
#pragma unroll
    for (int o = 1; o < 64; o <<= 1) v = fmaxf(v, __shfl_xor(v, o));
    return v;
}
__device__ __forceinline__ float u2f(unsigned u) { return __builtin_bit_cast(float, u); }
__device__ __forceinline__ unsigned f2u(float f) { return __builtin_bit_cast(unsigned, f); }
__device__ __forceinline__ float xmax_rows(float x) {
    auto r = __builtin_amdgcn_permlane16_swap(f2u(x), f2u(x), false, false); const unsigned r0 = r[0], r1 = r[1]; const float m = fmaxf(u2f(r0), u2f(r1));
    auto q = __builtin_amdgcn_permlane32_swap(f2u(m), f2u(m), false, false); const unsigned q0 = q[0], q1 = q[1]; return fmaxf(u2f(q0), u2f(q1)); }
__device__ __forceinline__ float xsum_rows(float x) {
    auto r = __builtin_amdgcn_permlane16_swap(f2u(x), f2u(x), false, false); const unsigned r0 = r[0], r1 = r[1]; const float m = u2f(r0) + u2f(r1);
    auto q = __builtin_amdgcn_permlane32_swap(f2u(m), f2u(m), false, false); const unsigned q0 = q[0], q1 = q[1]; return u2f(q0) + u2f(q1); }
__device__ __forceinline__ float swapsum32(float a, float b) {
    auto r = __builtin_amdgcn_permlane32_swap(f2u(a), f2u(b), false, false); const unsigned r0 = r[0], r1 = r[1]; return u2f(r0) + u2f(r1); }
__device__ __forceinline__ float swapsum16(float a, float b) {
    auto r = __builtin_amdgcn_permlane16_swap(f2u(a), f2u(b), false, false); const unsigned r0 = r[0], r1 = r[1]; return u2f(r0) + u2f(r1); }
__device__ __forceinline__ int hw_lane() { unsigned ones = ~0u; asm volatile("" : "+s"(ones)); return (int)__builtin_amdgcn_mbcnt_hi(ones, __builtin_amdgcn_mbcnt_lo(ones, 0u)); }
__device__ __forceinline__ f32x4 mfma16(bf16x8 a, bf16x8 b, f32x4 c) { return __builtin_amdgcn_mfma_f32_16x16x32_bf16(a, b, c, 0, 0, 0); }
__device__ __forceinline__ bf16x8 lfrag(const LAS unsigned char* base, int row, int pitch, int col) { return *(const LAS bf16x8*)(base + row * pitch + col * 2); }

#define XB_TMO      128
#define XB_XCNT(j)  (256  + 64 * (j))
#define XB_XSUB(j)  (1280 + 64 * (j))
#define XB_XGEN(j)  (2304 + 64 * (j))
#define XB_TOP      3328
#define XB_TOPGEN   3392
#define XCD_BAR_WORDS 3456
#define XB_SPIN_CAP (1u << 18)

__device__ __forceinline__ unsigned xb_ld(unsigned* p)              { return __hip_atomic_load(p, __ATOMIC_RELAXED, __HIP_MEMORY_SCOPE_AGENT); }
__device__ __forceinline__ unsigned xb_add(unsigned* p, unsigned v) { return __hip_atomic_fetch_add(p, v, __ATOMIC_RELAXED, __HIP_MEMORY_SCOPE_AGENT); }
__device__ __forceinline__ unsigned xb_xcc_id() { return (unsigned)__builtin_amdgcn_s_getreg((3 << 11) | 20) & 0xFu; }
#define XB_SPIN(cond, bar) do { unsigned _sp = 0; while (cond) { __builtin_amdgcn_s_sleep(1); \
    if ((++_sp & 255u) == 0u) { if (xb_ld(&(bar)[XB_TMO])) break; if (_sp > XB_SPIN_CAP) { atomicAdd(&(bar)[XB_TMO], 1u); break; } } } } while (0)

struct XcdBarrier {
    unsigned* bar; unsigned x;
    volatile LAS unsigned* st;
};

__device__ __forceinline__ XcdBarrier xcd_barrier_post(unsigned* bar, volatile LAS unsigned* st) {
    XcdBarrier b; b.bar = bar; b.x = xb_xcc_id(); b.st = st;
    if (threadIdx.x == 0) (void)xb_add(&bar[XB_XCNT(b.x)], 1u);
    return b;
}
__device__ __forceinline__ void xcd_barrier_complete(unsigned* bar, unsigned x, unsigned& nloc, unsigned& nx) {
    const unsigned G = gridDim.x * gridDim.y * gridDim.z;
    unsigned sum, cnt, mine, sp = 0u;
    for (;;) {
        sum = 0u; cnt = 0u; mine = 0u;
#pragma unroll
        for (unsigned j = 0; j < 16; ++j) { const unsigned c = xb_ld(&bar[XB_XCNT(j)]); sum += c; cnt += (c > 0u) ? 1u : 0u; mine = (j == x) ? c : mine; }
        if (sum == G) break;
        __builtin_amdgcn_s_sleep(1);
        if ((++sp & 255u) == 0u) { if (xb_ld(&bar[XB_TMO])) break; if (sp > XB_SPIN_CAP) { atomicAdd(&bar[XB_TMO], 1u); break; } }
    }
    nloc = mine > 0u ? mine : 1u; nx = cnt > 0u ? cnt : 1u;
}

__device__ __forceinline__ void xcd_barrier(const XcdBarrier& b, const bool t0  ) {
    asm volatile("s_waitcnt vmcnt(0)" ::: "memory");
    __syncthreads();
    if (t0) {
        unsigned* bar = b.bar;
        __builtin_amdgcn_s_waitcnt(0);
        unsigned nloc = b.st[0], nx = b.st[1];
        if (nloc == 0u) { xcd_barrier_complete(bar, b.x, nloc, nx); b.st[0] = nloc; b.st[1] = nx; }
        const unsigned old = xb_add(&bar[XB_XSUB(b.x)], 1u);
        const unsigned gen = old / nloc;
        if (old + 1u == (gen + 1u) * nloc) {
            __builtin_amdgcn_fence(__ATOMIC_RELEASE, "agent");
            asm volatile("s_waitcnt vmcnt(0)" ::: "memory");
            const unsigned og = xb_add(&bar[XB_TOP], 1u);
            const unsigned tg = og / nx;
            if (og + 1u == (tg + 1u) * nx) xb_add(&bar[XB_TOPGEN], 1u);
            else XB_SPIN(xb_ld(&bar[XB_TOPGEN]) == tg, bar);
            __builtin_amdgcn_fence(__ATOMIC_ACQUIRE, "agent");
            xb_add(&bar[XB_XGEN(b.x)], 1u);
            asm volatile("s_waitcnt vmcnt(0)" ::: "memory");
        } else {
            XB_SPIN(xb_ld(&bar[XB_XGEN(b.x)]) == gen, bar);
            __builtin_amdgcn_fence(__ATOMIC_ACQUIRE, "agent");
            asm volatile("s_waitcnt vmcnt(0)" ::: "memory");
        }
    }
    __syncthreads();
}

__device__ __forceinline__ unsigned pack4_fp8(float a, float b, float c2, float d) {
    a = __builtin_amdgcn_fmed3f(a, -448.f, 448.f); b = __builtin_amdgcn_fmed3f(b, -448.f, 448.f); c2 = __builtin_amdgcn_fmed3f(c2, -448.f, 448.f); d = __builtin_amdgcn_fmed3f(d, -448.f, 448.f);
    int p = 0; p = __builtin_amdgcn_cvt_pk_fp8_f32(a, b, p, false); p = __builtin_amdgcn_cvt_pk_fp8_f32(c2, d, p, true); return (unsigned)p; }
template <bool ILV> struct TrItem { const float* W; bf16_t* WT; int k0, n0, d0; };
template <bool ILV, bool O8 = false> __device__ __forceinline__ TrItem<ILV> tr_decode(const float* W, int batch_per, int K, int N, int Npad, bf16_t* WT, int it) {
    const int bi = it / batch_per, item = it - bi * batch_per;
    const int nblk = Npad / 64, kb = item / nblk, nb = item - kb * nblk, n0 = 64 * nb;
    const int d0 = ILV ? (n0 < DFF ? 256 * (n0 >> 7) + (n0 & 127) : 256 * ((n0 - DFF) >> 7) + 128 + ((n0 - DFF) & 127)) : n0;
    return TrItem<ILV>{W + (size_t)bi * K * N, WT + (size_t)bi * Npad * K / (O8 ? 2 : 1), 64 * kb, n0, d0};
}
template <bool ILV> __device__ __forceinline__ void tr_load(f32x4 (&v)[16], const TrItem<ILV>& t, int N, int lane) {
    const int r4 = lane >> 4, c4 = lane & 15, nn = t.n0 + 4 * c4; const bool ok = nn < N;
#pragma unroll
    for (int i = 0; i < 16; ++i) v[i] = ok ? __builtin_nontemporal_load((const f32x4*)(t.W + (size_t)(t.k0 + 4 * i + r4) * N + nn)) : (f32x4){0.f, 0.f, 0.f, 0.f};
}
template <bool ILV, bool O8> __device__ __forceinline__ void tr_store(const f32x4 (&v)[16], const TrItem<ILV>& t, int K, LAS float* scr, int lane, float osc) {
    const int r4 = lane >> 4, c4 = lane & 15;
#pragma unroll
    for (int i = 0; i < 16; ++i) { LAS float* s = scr + (4 * i + r4) * 65 + 4 * c4; s[0] = v[i].x; s[1] = v[i].y; s[2] = v[i].z; s[3] = v[i].w; }
    LDS_WAIT(); asm volatile("" ::: "memory");
    const int c = lane & 7;
#pragma unroll
    for (int j = 0; j < 8; ++j) { const int n = (lane >> 3) + 8 * j; const LAS float* s = scr + (8 * c) * 65 + n;
        if (O8) { u32x2 o; o.x = pack4_fp8(s[0 * 65] * osc, s[1 * 65] * osc, s[2 * 65] * osc, s[3 * 65] * osc); o.y = pack4_fp8(s[4 * 65] * osc, s[5 * 65] * osc, s[6 * 65] * osc, s[7 * 65] * osc);
            *(u32x2*)((unsigned char*)t.WT + (size_t)(t.d0 + n) * K + t.k0 + 8 * c) = o; }
        else { u32x4 o; o.x = pk2(s[0 * 65], s[1 * 65]); o.y = pk2(s[2 * 65], s[3 * 65]); o.z = pk2(s[4 * 65], s[5 * 65]); o.w = pk2(s[6 * 65], s[7 * 65]);
            *(u32x4*)(t.WT + (size_t)(t.d0 + n) * K + t.k0 + 8 * c) = o; } }
    LDS_WAIT(); asm volatile("" ::: "memory");
}
template <bool ILV = false, bool O8 = false> __device__ __forceinline__ void convert_matrix(const float* W, int batch, int K, int N, int Npad, bf16_t* WT, LAS float* scr, int gw, int NGW, int lane, float osc = 1.0f) {
    const int per = (K / 64) * (Npad / 64), total = batch * per;
    int it = gw; if (it >= total) return;
    f32x4 va[16], vb[16];
    TrItem<ILV> ta = tr_decode<ILV, O8>(W, per, K, N, Npad, WT, it), tb = ta;
    tr_load<ILV>(va, ta, N, lane);
    for (;;) {
        int nx = it + NGW; const bool hb = nx < total;
        if (hb) { tb = tr_decode<ILV, O8>(W, per, K, N, Npad, WT, nx); tr_load<ILV>(vb, tb, N, lane); }
        tr_store<ILV, O8>(va, ta, K, scr, lane, osc);
        if (!hb) break;
        it = nx; nx = it + NGW; const bool ha = nx < total;
        if (ha) { ta = tr_decode<ILV, O8>(W, per, K, N, Npad, WT, nx); tr_load<ILV>(va, ta, N, lane); }
        tr_store<ILV, O8>(vb, tb, K, scr, lane, osc);
        if (!ha) break;
        it = nx;
    }
}
__device__ __forceinline__ void rmsnorm_rows_bf16(const float* X, const float* g, bf16_t* O, int gw, int NGW, int lane) {
    f32x4 gg[16];
#pragma unroll
    for (int j = 0; j < 16; ++j) gg[j] = ((const f32x4*)g)[lane + 64 * j];
    f32x4 nx[16];
    if (gw < M) { const f32x4* xr = (const f32x4*)(X + (size_t)gw * D) + lane;
#pragma unroll
        for (int j = 0; j < 16; ++j) nx[j] = xr[64 * j]; }
    for (int m = gw; m < M; m += NGW) {
        f32x4 v[16]; float s = 0.f;
#pragma unroll
        for (int j = 0; j < 16; ++j) { v[j] = nx[j]; s += (v[j].x * v[j].x + v[j].y * v[j].y) + (v[j].z * v[j].z + v[j].w * v[j].w); }
        if (m + NGW < M) { const f32x4* xn = (const f32x4*)(X + (size_t)(m + NGW) * D) + lane;
#pragma unroll
            for (int j = 0; j < 16; ++j) nx[j] = xn[64 * j]; }
        const float rstd = 1.0f / sqrtf(wave_sum(s) * (1.0f / D) + RMS_EPS);
        u32x2* o8 = (u32x2*)(O + (size_t)m * D) + lane;
#pragma unroll
        for (int j = 0; j < 16; ++j) { u32x2 w; w.x = pk2(v[j].x * rstd * gg[j].x, v[j].y * rstd * gg[j].y); w.y = pk2(v[j].z * rstd * gg[j].z, v[j].w * rstd * gg[j].w); o8[64 * j] = w; }
    }
}
template <int OUTM  > __device__ __forceinline__ void rmsnorm_rows_from_bf16(const bf16_t* X, const float* g, void* O, int gw, int NGW, int lane) {
    f32x4 gg[8][2];
#pragma unroll
    for (int j = 0; j < 8; ++j) { const int c0 = 8 * (lane + 64 * j); gg[j][0] = *(const f32x4*)(g + c0); gg[j][1] = *(const f32x4*)(g + c0 + 4); }
    u32x4 w[8];
    if (gw < M) { const u32x4* xr = (const u32x4*)(X + (size_t)gw * D) + lane;
#pragma unroll
        for (int j = 0; j < 8; ++j) w[j] = xr[64 * j]; }
    for (int m = gw; m < M; m += NGW) {
        float v[8][8]; float s = 0.f;
#pragma unroll
        for (int j = 0; j < 8; ++j) { v[j][0] = bflo(w[j].x); v[j][1] = bfhi(w[j].x); v[j][2] = bflo(w[j].y); v[j][3] = bfhi(w[j].y); v[j][4] = bflo(w[j].z); v[j][5] = bfhi(w[j].z); v[j][6] = bflo(w[j].w); v[j][7] = bfhi(w[j].w);
#pragma unroll
            for (int e = 0; e < 8; ++e) s += v[j][e] * v[j][e]; }
        if (m + NGW < M) { const u32x4* xn = (const u32x4*)(X + (size_t)(m + NGW) * D) + lane;
#pragma unroll
            for (int j = 0; j < 8; ++j) w[j] = xn[64 * j]; }
        const float rstd = 1.0f / sqrtf(wave_sum(s) * (1.0f / D) + RMS_EPS);
#pragma unroll
        for (int j = 0; j < 8; ++j) { const int c0 = 8 * (lane + 64 * j); const f32x4 g0 = gg[j][0], g1 = gg[j][1];
            const float o0 = v[j][0] * rstd * g0.x, o1 = v[j][1] * rstd * g0.y, o2 = v[j][2] * rstd * g0.z, o3 = v[j][3] * rstd * g0.w, o4 = v[j][4] * rstd * g1.x, o5 = v[j][5] * rstd * g1.y, o6 = v[j][6] * rstd * g1.z, o7 = v[j][7] * rstd * g1.w;
            if (OUTM == 1) { float* op = (float*)O + (size_t)m * D + c0; *(f32x4*)op = (f32x4){o0, o1, o2, o3}; *(f32x4*)(op + 4) = (f32x4){o4, o5, o6, o7}; }
            else if (OUTM == 2) { u32x2 ow; ow.x = pack4_fp8(o0 * HN8_SC, o1 * HN8_SC, o2 * HN8_SC, o3 * HN8_SC); ow.y = pack4_fp8(o4 * HN8_SC, o5 * HN8_SC, o6 * HN8_SC, o7 * HN8_SC); *(u32x2*)((unsigned char*)O + (size_t)m * D + c0) = ow; }
            else { u32x4 ow; ow.x = pk2(o0, o1); ow.y = pk2(o2, o3); ow.z = pk2(o4, o5); ow.w = pk2(o6, o7); *(u32x4*)((bf16_t*)O + (size_t)m * D + c0) = ow; } }
    }
}
__device__ __forceinline__ void rmsnorm_rows_f32(const float* X, const float* g, float* O, int gw, int NGW, int lane) {
    for (int m = gw; m < M; m += NGW) {
        const f32x4* xr = (const f32x4*)(X + (size_t)m * D) + lane;
        f32x4 v[16]; float s = 0.f;
#pragma unroll
        for (int j = 0; j < 16; ++j) { v[j] = xr[64 * j]; s += (v[j].x * v[j].x + v[j].y * v[j].y) + (v[j].z * v[j].z + v[j].w * v[j].w); }
        const float rstd = 1.0f / sqrtf(wave_sum(s) * (1.0f / D) + RMS_EPS);
        f32x4* o = (f32x4*)(O + (size_t)m * D) + lane;
#pragma unroll
        for (int j = 0; j < 16; ++j) { const f32x4 gg = ((const f32x4*)g)[lane + 64 * j]; o[64 * j] = v[j] * rstd * gg; }
    }
}

__device__ __forceinline__ void gla_pre_unit(int cidx, int h, bf16_t* Q, bf16_t* Kb, const float* A1, const float* w_a2, const float* b_a, bf16_t* KT, float* EBL, LAS float* tot, int tid) {
    const int dg = tid & 31, tq = tid >> 5; const int d0 = h * 256 + 8 * dg; const int m0 = cidx * 64 + 4 * tq;
    float acc[4][8];
    { const f32x4 b0 = *(const f32x4*)(b_a + d0), b1 = *(const f32x4*)(b_a + d0 + 4);
#pragma unroll
      for (int i = 0; i < 4; ++i) { acc[i][0] = b0.x; acc[i][1] = b0.y; acc[i][2] = b0.z; acc[i][3] = b0.w; acc[i][4] = b1.x; acc[i][5] = b1.y; acc[i][6] = b1.z; acc[i][7] = b1.w; } }
#pragma unroll
    for (int jq = 0; jq < 4; ++jq) {
        f32x4 a[4];
#pragma unroll
        for (int i = 0; i < 4; ++i) a[i] = *(const f32x4*)(A1 + (size_t)(m0 + i) * 16 + 4 * jq);
#pragma unroll
        for (int jj = 0; jj < 4; ++jj) { const int j = 4 * jq + jj;
            const f32x4 w0 = *(const f32x4*)(w_a2 + (size_t)j * 2048 + d0), w1 = *(const f32x4*)(w_a2 + (size_t)j * 2048 + d0 + 4);
#pragma unroll
            for (int i = 0; i < 4; ++i) { const float av = a[i][jj];
                acc[i][0] += av * w0.x; acc[i][1] += av * w0.y; acc[i][2] += av * w0.z; acc[i][3] += av * w0.w; acc[i][4] += av * w1.x; acc[i][5] += av * w1.y; acc[i][6] += av * w1.z; acc[i][7] += av * w1.w; } }
    }
#pragma unroll
    for (int i = 0; i < 4; ++i)
#pragma unroll
        for (int e = 0; e < 8; ++e) { const float x = acc[i][e]; acc[i][e] = (fminf(x, 0.f) - log1pf(__expf(-fabsf(x)))) * (1.0f / 16.0f); }
#pragma unroll
    for (int i = 1; i < 4; ++i)
#pragma unroll
        for (int e = 0; e < 8; ++e) acc[i][e] += acc[i - 1][e];
    *(LAS f32x4*)(tot + tq * 256 + 8 * dg) = (f32x4){acc[3][0], acc[3][1], acc[3][2], acc[3][3]};
    *(LAS f32x4*)(tot + tq * 256 + 8 * dg + 4) = (f32x4){acc[3][4], acc[3][5], acc[3][6], acc[3][7]};
    __syncthreads();
    float pre[8], all[8];
#pragma unroll
    for (int e = 0; e < 8; ++e) { pre[e] = 0.f; all[e] = 0.f; }
#pragma unroll
    for (int q = 0; q < 16; ++q) { const f32x4 t0 = *(const LAS f32x4*)(tot + q * 256 + 8 * dg), t1 = *(const LAS f32x4*)(tot + q * 256 + 8 * dg + 4);
        const float tv[8] = {t0.x, t0.y, t0.z, t0.w, t1.x, t1.y, t1.z, t1.w};
#pragma unroll
        for (int e = 0; e < 8; ++e) { all[e] += tv[e]; if (q < tq) pre[e] += tv[e]; } }
    float kv[4][8];
#pragma unroll
    for (int i = 0; i < 4; ++i) { const size_t off = (size_t)(m0 + i) * 2048 + d0;
        const u32x4 qw = *(const u32x4*)(Q + off), kw = *(const u32x4*)(Kb + off);
        const unsigned qa[4] = {qw.x, qw.y, qw.z, qw.w}, ka[4] = {kw.x, kw.y, kw.z, kw.w};
        float qo[8];
#pragma unroll
        for (int e2 = 0; e2 < 4; ++e2) { const float b0 = pre[2 * e2] + acc[i][2 * e2], b1 = pre[2 * e2 + 1] + acc[i][2 * e2 + 1];
            qo[2 * e2] = bflo(qa[e2]) * __expf(b0) * 0.0625f; qo[2 * e2 + 1] = bfhi(qa[e2]) * __expf(b1) * 0.0625f;
            kv[i][2 * e2] = bflo(ka[e2]) * __expf(-b0); kv[i][2 * e2 + 1] = bfhi(ka[e2]) * __expf(-b1); }
        u32x4 qs, ks; qs.x = pk2(qo[0], qo[1]); qs.y = pk2(qo[2], qo[3]); qs.z = pk2(qo[4], qo[5]); qs.w = pk2(qo[6], qo[7]);
        ks.x = pk2(kv[i][0], kv[i][1]); ks.y = pk2(kv[i][2], kv[i][3]); ks.z = pk2(kv[i][4], kv[i][5]); ks.w = pk2(kv[i][6], kv[i][7]);
        *(u32x4*)(Q + off) = qs; *(u32x4*)(Kb + off) = ks; }
#pragma unroll
    for (int e = 0; e < 8; ++e) { u32x2 w; w.x = pk2(kv[0][e], kv[1][e]); w.y = pk2(kv[2][e], kv[3][e]); *(u32x2*)(KT + ((size_t)cidx * 2048 + d0 + e) * 64 + 4 * tq) = w; }
    if (tq == 0) { *(f32x4*)(EBL + (size_t)cidx * 2048 + d0) = (f32x4){__expf(all[0]), __expf(all[1]), __expf(all[2]), __expf(all[3])};
                   *(f32x4*)(EBL + (size_t)cidx * 2048 + d0 + 4) = (f32x4){__expf(all[4]), __expf(all[5]), __expf(all[6]), __expf(all[7])}; }
    __syncthreads();
}

constexpr int SC_LQ = 0, SC_LK = 33792, SC_LKT = 67584, SC_LVT = 104448, SC_LP = 113664, SC_LST = 122880, SC_LEBL = 156672;
static_assert(SC_LEBL + 1024 <= MISC_OFF, "scan LDS map");
struct ScanRegs { u32x4 q[4], k[4], kt[4], v; float ebl; };
__device__ __forceinline__ void gla_scan_load(ScanRegs& R, int cidx, int h, int vs, const bf16_t* Q, const bf16_t* Kb, const bf16_t* KT, const bf16_t* V, const float* EBL, int tid) {
#pragma unroll
    for (int i = 0; i < 4; ++i) { const int idx = tid + 512 * i, row = idx >> 5, ch = idx & 31; const size_t off = (size_t)(cidx * 64 + row) * 2048 + h * 256 + ch * 8;
        R.q[i] = *(const u32x4*)(Q + off); R.k[i] = *(const u32x4*)(Kb + off); }
#pragma unroll
    for (int i = 0; i < 4; ++i) { const int idx = tid + 512 * i, row = idx >> 3, ch = idx & 7;
        R.kt[i] = *(const u32x4*)(KT + ((size_t)cidx * 2048 + h * 256 + row) * 64 + ch * 8); }
    { const int s = tid >> 3, ch = tid & 7; R.v = *(const u32x4*)(V + (size_t)(cidx * 64 + s) * 4096 + h * 512 + vs * 64 + ch * 8); }
    R.ebl = EBL[(size_t)cidx * 2048 + h * 256 + (tid & 255)];
}
__device__ __forceinline__ void gla_scan_store(const ScanRegs& R, LAS unsigned char* lds, int tid) {
#pragma unroll
    for (int i = 0; i < 4; ++i) { const int idx = tid + 512 * i, row = idx >> 5, ch = idx & 31;
        *(LAS u32x4*)(lds + SC_LQ + row * 528 + ch * 16) = R.q[i]; *(LAS u32x4*)(lds + SC_LK + row * 528 + ch * 16) = R.k[i]; }
#pragma unroll
    for (int i = 0; i < 4; ++i) { const int idx = tid + 512 * i, row = idx >> 3, ch = idx & 7;
        *(LAS u32x4*)(lds + SC_LKT + row * 144 + ch * 16) = R.kt[i]; }
    { const int s = tid >> 3, ch = tid & 7; const unsigned va[4] = {R.v.x, R.v.y, R.v.z, R.v.w};
#pragma unroll
      for (int e2 = 0; e2 < 4; ++e2) { *(LAS bf16_t*)(lds + SC_LVT + (ch * 8 + 2 * e2) * 144 + s * 2) = (bf16_t)(va[e2] & 0xffffu); *(LAS bf16_t*)(lds + SC_LVT + (ch * 8 + 2 * e2 + 1) * 144 + s * 2) = (bf16_t)(va[e2] >> 16); } }
    if (tid < 256) ((LAS float*)(lds + SC_LEBL))[tid] = R.ebl;
}
__device__ __forceinline__ void gla_scan_unit(int b, int h, int vs, const bf16_t* Q, const bf16_t* Kb, const bf16_t* KT, const bf16_t* V, const float* EBL, bf16_t* ORAW, LAS unsigned char* lds, int tid) {
    const int lane = tid & 63, w = __builtin_amdgcn_readfirstlane(tid >> 6), fr = lane & 15, fq = lane >> 4;
    f32x4 S[2][4];
#pragma unroll
    for (int a = 0; a < 2; ++a)
#pragma unroll
        for (int n = 0; n < 4; ++n) S[a][n] = (f32x4){0.f, 0.f, 0.f, 0.f};
    for (int i = tid; i < 33792 / 16; i += NTHR) ((LAS u32x4*)(lds + SC_LST))[i] = (u32x4){0u, 0u, 0u, 0u};
    ScanRegs R;
    gla_scan_load(R, b * 128, h, vs, Q, Kb, KT, V, EBL, tid);
    gla_scan_store(R, lds, tid);
    const int mt = w >> 1, nt0 = 2 * (w & 1);
    for (int c = 0; c < 128; ++c) {
        const int cidx = b * 128 + c;
        if (c + 1 < 128) gla_scan_load(R, cidx + 1, h, vs, Q, Kb, KT, V, EBL, tid);
        __syncthreads();
#pragma unroll
        for (int q = 0; q < 2; ++q) { const int nt = nt0 + q; f32x4 acc = (f32x4){0.f, 0.f, 0.f, 0.f};
            if (nt <= mt) {
#pragma unroll
                for (int ks = 0; ks < 8; ++ks) acc = mfma16(lfrag(lds + SC_LQ, 16 * mt + fr, 528, 32 * ks + 8 * fq), lfrag(lds + SC_LK, 16 * nt + fr, 528, 32 * ks + 8 * fq), acc); }
#pragma unroll
            for (int r = 0; r < 4; ++r) { const int t = 16 * mt + 4 * fq + r, s = 16 * nt + fr; *(LAS bf16_t*)(lds + SC_LP + t * 144 + s * 2) = (bf16_t)f2bf(s <= t ? acc[r] : 0.f); } }
        __syncthreads();
#pragma unroll
        for (int q = 0; q < 2; ++q) { const int nt = nt0 + q; f32x4 acc = (f32x4){0.f, 0.f, 0.f, 0.f};
#pragma unroll
            for (int ks = 0; ks < 2; ++ks) acc = mfma16(lfrag(lds + SC_LVT, 16 * nt + fr, 144, 32 * ks + 8 * fq), lfrag(lds + SC_LP, 16 * mt + fr, 144, 32 * ks + 8 * fq), acc);
#pragma unroll
            for (int ks = 0; ks < 8; ++ks) acc = mfma16(lfrag(lds + SC_LST, 16 * nt + fr, 528, 32 * ks + 8 * fq), lfrag(lds + SC_LQ, 16 * mt + fr, 528, 32 * ks + 8 * fq), acc);
            u32x2 ow; ow.x = pk2(acc[0], acc[1]); ow.y = pk2(acc[2], acc[3]); *(u32x2*)(ORAW + (size_t)(cidx * 64 + 16 * mt + fr) * 4096 + h * 512 + vs * 64 + 16 * nt + 4 * fq) = ow; }
#pragma unroll
        for (int mi = 0; mi < 2; ++mi) { const int dt = 2 * w + mi;
#pragma unroll
            for (int ks = 0; ks < 2; ++ks) { const bf16x8 a = lfrag(lds + SC_LKT, 16 * dt + fr, 144, 32 * ks + 8 * fq);
#pragma unroll
                for (int nt = 0; nt < 4; ++nt) S[mi][nt] = mfma16(a, lfrag(lds + SC_LVT, 16 * nt + fr, 144, 32 * ks + 8 * fq), S[mi][nt]); }
            const f32x4 eb = *(const LAS f32x4*)(lds + SC_LEBL + (16 * dt + 4 * fq) * 4);
#pragma unroll
            for (int nt = 0; nt < 4; ++nt) S[mi][nt] = S[mi][nt] * eb; }
        __syncthreads();
#pragma unroll
        for (int mi = 0; mi < 2; ++mi) { const int dt = 2 * w + mi;
#pragma unroll
            for (int nt = 0; nt < 4; ++nt) { u32x2 wv; wv.x = pk2(S[mi][nt][0], S[mi][nt][1]); wv.y = pk2(S[mi][nt][2], S[mi][nt][3]);
                *(LAS u32x2*)(lds + SC_LST + (16 * nt + fr) * 528 + (16 * dt + 4 * fq) * 2) = wv; } }
        if (c + 1 < 128) gla_scan_store(R, lds, tid);
    }
    __syncthreads();
}

__device__ __forceinline__ void gla_out_norm(const bf16_t* ORAW, const bf16_t* Rg, const float* g_out, bf16_t* OG, int gw, int NGW, int lane) {
    const f32x4 g0 = *(const f32x4*)(g_out + 4 * lane), g1 = *(const f32x4*)(g_out + 256 + 4 * lane);
    for (int m = gw; m < M; m += NGW) {
        const size_t rb = (size_t)m * 4096;
        u32x2 q0[8], q1[8], r0[8], r1[8];
#pragma unroll
        for (int h = 0; h < 8; ++h) { const size_t base = rb + h * 512;
            q0[h] = *(const u32x2*)(ORAW + base + 4 * lane); q1[h] = *(const u32x2*)(ORAW + base + 256 + 4 * lane);
            r0[h] = *(const u32x2*)(Rg + base + 4 * lane); r1[h] = *(const u32x2*)(Rg + base + 256 + 4 * lane); }
#pragma unroll
        for (int h = 0; h < 8; ++h) { const size_t base = rb + h * 512;
            const f32x4 v0 = (f32x4){bflo(q0[h].x), bfhi(q0[h].x), bflo(q0[h].y), bfhi(q0[h].y)}, v1 = (f32x4){bflo(q1[h].x), bfhi(q1[h].x), bflo(q1[h].y), bfhi(q1[h].y)};
            const float s = (v0.x * v0.x + v0.y * v0.y) + (v0.z * v0.z + v0.w * v0.w) + (v1.x * v1.x + v1.y * v1.y) + (v1.z * v1.z + v1.w * v1.w);
            const float rstd = 1.0f / sqrtf(wave_sum(s) * (1.0f / 512.0f) + RMS_EPS);
            float rr[8] = {bflo(r0[h].x), bfhi(r0[h].x), bflo(r0[h].y), bfhi(r0[h].y), bflo(r1[h].x), bfhi(r1[h].x), bflo(r1[h].y), bfhi(r1[h].y)};
#pragma unroll
            for (int e = 0; e < 8; ++e) rr[e] = rr[e] / (1.0f + __expf(-rr[e]));
            u32x2 o0, o1;
            o0.x = pk2(v0.x * rstd * g0.x * rr[0], v0.y * rstd * g0.y * rr[1]); o0.y = pk2(v0.z * rstd * g0.z * rr[2], v0.w * rstd * g0.w * rr[3]);
            o1.x = pk2(v1.x * rstd * g1.x * rr[4], v1.y * rstd * g1.y * rr[5]); o1.y = pk2(v1.z * rstd * g1.z * rr[6], v1.w * rstd * g1.w * rr[7]);
            *(u32x2*)(OG + base + 4 * lane) = o0; *(u32x2*)(OG + base + 256 + 4 * lane) = o1; }
    }
}

template <bool F8OUT> __device__ __forceinline__ void conv_fixup(const bf16_t* UH, const float* cw, const float* cb, bf16_t* ACT, int gtid, int ngt) {
    constexpr int NV = DFF / 8;
    for (int idx = gtid; idx < (M / 64) * NV; idx += ngt) {
        const int g = idx / NV, cv = idx - g * NV, c = 8 * cv, pn = c >> 7, l = c & 127;
        const bool first = (g & 127) == 0;
        float a[2][8];
        float y[2][2][8];
#pragma unroll
        for (int half = 0; half < 2; ++half) {
            const int cc = c + half * DFF; const size_t hc = (size_t)pn * 256 + half * 128 + l;
            float um2[8], um1[8], u0[8], u1[8];
            const u32x4 z = (u32x4){0u, 0u, 0u, 0u};
            const u32x4 q2 = first ? z : *(const u32x4*)(UH + ((size_t)(g - 1) * 4 + 0) * DFF2 + hc), q1 = first ? z : *(const u32x4*)(UH + ((size_t)(g - 1) * 4 + 1) * DFF2 + hc);
            const u32x4 p0 = *(const u32x4*)(UH + ((size_t)g * 4 + 2) * DFF2 + hc), p1 = *(const u32x4*)(UH + ((size_t)g * 4 + 3) * DFF2 + hc);
            const unsigned q2a[4] = {q2.x, q2.y, q2.z, q2.w}, q1a[4] = {q1.x, q1.y, q1.z, q1.w}, p0a[4] = {p0.x, p0.y, p0.z, p0.w}, p1a[4] = {p1.x, p1.y, p1.z, p1.w};
#pragma unroll
            for (int e2 = 0; e2 < 4; ++e2) { um2[2 * e2] = bflo(q2a[e2]); um2[2 * e2 + 1] = bfhi(q2a[e2]); um1[2 * e2] = bflo(q1a[e2]); um1[2 * e2 + 1] = bfhi(q1a[e2]);
                u0[2 * e2] = bflo(p0a[e2]); u0[2 * e2 + 1] = bfhi(p0a[e2]); u1[2 * e2] = bflo(p1a[e2]); u1[2 * e2 + 1] = bfhi(p1a[e2]); }
#pragma unroll
            for (int e = 0; e < 8; ++e) { const float w0 = cw[cc + e], w1 = cw[DFF2 + cc + e], w2 = cw[2 * DFF2 + cc + e], bb = cb[cc + e];
                y[0][half][e] = bb + w0 * um2[e] + w1 * um1[e] + w2 * u0[e];
                y[1][half][e] = bb + w0 * um1[e] + w1 * u0[e] + w2 * u1[e]; }
        }
#pragma unroll
        for (int r = 0; r < 2; ++r) {
#pragma unroll
            for (int e = 0; e < 8; ++e) a[r][e] = y[r][0][e] / (1.0f + __expf(-y[r][0][e])) * y[r][1][e];
            if (F8OUT) { u32x2 o; o.x = pack4_fp8(a[r][0] * ACT_SC, a[r][1] * ACT_SC, a[r][2] * ACT_SC, a[r][3] * ACT_SC); o.y = pack4_fp8(a[r][4] * ACT_SC, a[r][5] * ACT_SC, a[r][6] * ACT_SC, a[r][7] * ACT_SC);
                *(u32x2*)((unsigned char*)ACT + (size_t)(64 * g + r) * DFF + c) = o; }
            else { u32x4 o; o.x = pk2(a[r][0], a[r][1]); o.y = pk2(a[r][2], a[r][3]); o.z = pk2(a[r][4], a[r][5]); o.w = pk2(a[r][6], a[r][7]);
                *(u32x4*)(ACT + (size_t)(64 * g + r) * DFF + c) = o; } }
    }
}

__device__ __forceinline__ void dsa_norm(const float* Z, const float* g_q, const float* g_kv, bf16_t* CQN, bf16_t* CKV, bf16_t* KIDX, float* WIDX, int gw, int NGW, int lane) {
    f32x4 gq[4], gk[2];
#pragma unroll
    for (int j = 0; j < 4; ++j) gq[j] = *(const f32x4*)(g_q + 4 * (lane + 64 * j));
#pragma unroll
    for (int j = 0; j < 2; ++j) gk[j] = *(const f32x4*)(g_kv + 4 * (lane + 64 * j));
    f32x4 nq[4], nkv[2], nk = (f32x4){0.f, 0.f, 0.f, 0.f}, nw = nk;
#define DSA_LOADROW(mm) do { const float* z_ = Z + (size_t)(mm) * DSA_IN_NP; _Pragma("unroll") for (int j = 0; j < 4; ++j) nq[j] = *(const f32x4*)(z_ + 4 * (lane + 64 * j)); \
        _Pragma("unroll") for (int j = 0; j < 2; ++j) nkv[j] = *(const f32x4*)(z_ + 1024 + 4 * (lane + 64 * j)); \
        nk = *(const f32x4*)(z_ + 1536 + 4 * (lane & 31)); nw = *(const f32x4*)(z_ + 1664 + 4 * (lane & 15)); } while (0)
    if (gw < M) DSA_LOADROW(gw);
    for (int m = gw; m < M; m += NGW) {
        f32x4 q[4], kv[2]; const f32x4 k = nk, wv = nw; float s = 0.f, s2 = 0.f;
#pragma unroll
        for (int j = 0; j < 4; ++j) { q[j] = nq[j]; s += (q[j].x * q[j].x + q[j].y * q[j].y) + (q[j].z * q[j].z + q[j].w * q[j].w); }
#pragma unroll
        for (int j = 0; j < 2; ++j) { kv[j] = nkv[j]; s2 += (kv[j].x * kv[j].x + kv[j].y * kv[j].y) + (kv[j].z * kv[j].z + kv[j].w * kv[j].w); }
        if (m + NGW < M) DSA_LOADROW(m + NGW);
        const float rq = 1.0f / sqrtf(wave_sum(s) * (1.0f / 1024.0f) + RMS_EPS);
#pragma unroll
        for (int j = 0; j < 4; ++j) { const f32x4 gg = gq[j]; u32x2 w; w.x = pk2(q[j].x * rq * gg.x, q[j].y * rq * gg.y); w.y = pk2(q[j].z * rq * gg.z, q[j].w * rq * gg.w);
            *(u32x2*)(CQN + (size_t)m * 1024 + 4 * (lane + 64 * j)) = w; }
        const float rk = 1.0f / sqrtf(wave_sum(s2) * (1.0f / 512.0f) + RMS_EPS);
#pragma unroll
        for (int j = 0; j < 2; ++j) { const f32x4 gg = gk[j]; u32x2 w; w.x = pk2(kv[j].x * rk * gg.x, kv[j].y * rk * gg.y); w.y = pk2(kv[j].z * rk * gg.z, kv[j].w * rk * gg.w);
            *(u32x2*)(CKV + (size_t)m * 512 + 4 * (lane + 64 * j)) = w; }
        if (lane < 32) { u32x2 w; w.x = pk2(k.x, k.y); w.y = pk2(k.z, k.w); *(u32x2*)(KIDX + (size_t)m * 128 + 4 * lane) = w; }
        if (lane < 16) { *(f32x4*)(WIDX + (size_t)m * 64 + 4 * lane) = wv * 0.01104854345603981f; }
    }
#undef DSA_LOADROW
}

constexpr int IX_PITCH = 272, IX_BUF = 64 * IX_PITCH;
__device__ __forceinline__ void indexer_group(int u, const bf16_t* QIDX, const bf16_t* KIDX, const float* WIDX, float* SCo, LAS unsigned char* lds, int tid) {
    const int lane = tid & 63, w = __builtin_amdgcn_readfirstlane(tid >> 6), fr = lane & 15, fq = lane >> 4;
    const int m0 = 16 * u, b = m0 >> 13, t0 = m0 & (SEQ - 1);
    if (t0 + 15 < 256) return;
    const int ng = (t0 + 15 + 64) >> 6;
    const int mA = m0 + 2 * w;
    bf16x8 a[2][4][4]; f32x4 wv[2][4]; bf16x8 abar[4];
#pragma unroll
    for (int ks = 0; ks < 4; ++ks) abar[ks] = (bf16x8){0, 0, 0, 0, 0, 0, 0, 0};
#pragma unroll
    for (int tk = 0; tk < 2; ++tk) {
        float qs[4][8];
#pragma unroll
        for (int ks = 0; ks < 4; ++ks)
#pragma unroll
            for (int e = 0; e < 8; ++e) qs[ks][e] = 0.f;
#pragma unroll
        for (int mt = 0; mt < 4; ++mt) {
            const float wrow = 0.5f * WIDX[(size_t)(mA + tk) * 64 + 16 * mt + fr];
#pragma unroll
            for (int ks = 0; ks < 4; ++ks) { a[tk][mt][ks] = *(const bf16x8*)(QIDX + (size_t)(mA + tk) * 8192 + (16 * mt + fr) * 128 + 32 * ks + 8 * fq);
                const u32x4 aw = __builtin_bit_cast(u32x4, a[tk][mt][ks]);
                qs[ks][0] += wrow * bflo(aw.x); qs[ks][1] += wrow * bfhi(aw.x); qs[ks][2] += wrow * bflo(aw.y); qs[ks][3] += wrow * bfhi(aw.y);
                qs[ks][4] += wrow * bflo(aw.z); qs[ks][5] += wrow * bfhi(aw.z); qs[ks][6] += wrow * bflo(aw.w); qs[ks][7] += wrow * bfhi(aw.w); }
            wv[tk][mt] = *(const f32x4*)(WIDX + (size_t)(mA + tk) * 64 + 16 * mt + 4 * fq) * 0.5f; }
#pragma unroll
        for (int ks = 0; ks < 4; ++ks) {
#pragma unroll
            for (int e = 0; e < 8; ++e) { float v = qs[ks][e];
                v += __builtin_bit_cast(float, __builtin_amdgcn_update_dpp(0, __builtin_bit_cast(int, v), 0xB1, 0xf, 0xf, false));
                v += __builtin_bit_cast(float, __builtin_amdgcn_update_dpp(0, __builtin_bit_cast(int, v), 0x4E, 0xf, 0xf, false));
                v += __builtin_bit_cast(float, __builtin_amdgcn_update_dpp(0, __builtin_bit_cast(int, v), 0x141, 0xf, 0xf, false));
                v += __builtin_bit_cast(float, __builtin_amdgcn_update_dpp(0, __builtin_bit_cast(int, v), 0x140, 0xf, 0xf, false));
                qs[ks][e] = v; }
            const u32x4 pkd = (u32x4){pk2(qs[ks][0], qs[ks][1]), pk2(qs[ks][2], qs[ks][3]), pk2(qs[ks][4], qs[ks][5]), pk2(qs[ks][6], qs[ks][7])};
            if (fr == tk) abar[ks] = __builtin_bit_cast(bf16x8, pkd); }
    }
    const int krow = tid >> 3, kc = (tid & 7) * 2;
    const bf16_t* kp = KIDX + ((size_t)b * SEQ + krow) * 128 + kc * 8;
    u32x4 r0 = *(const u32x4*)kp, r1 = *(const u32x4*)(kp + 8);
    *(LAS u32x4*)(lds + krow * IX_PITCH + kc * 16) = r0; *(LAS u32x4*)(lds + krow * IX_PITCH + kc * 16 + 16) = r1;
    __syncthreads();
    for (int g = 0; g < ng; ++g) {
        if (g + 1 < ng) { const bf16_t* kn = kp + (size_t)(g + 1) * 64 * 128; r0 = *(const u32x4*)kn; r1 = *(const u32x4*)(kn + 8); }
        const LAS unsigned char* cur = lds + (g & 1) * IX_BUF;
        float p[2][4];
        bf16x8 bb[4];
#pragma unroll
        for (int ks = 0; ks < 4; ++ks) bb[ks] = *(const LAS bf16x8*)(cur + fr * IX_PITCH + (4 * ks + fq) * 16);
#pragma unroll
        for (int nt = 0; nt < 4; ++nt) {
            float pn[2] = {0.f, 0.f};
            f32x4 acc[5][2];
#pragma unroll
            for (int st = 0; st < 24; ++st) {
                if (st < 20) { const int q = st >> 2, ks = st & 3;
#pragma unroll
                    for (int j = 0; j < 2; ++j) { const int ch = 2 * q + j; if (ch < 9) {
                        const bf16x8 af = ch == 0 ? abar[ks] : a[(ch - 1) >> 2][(ch - 1) & 3][ks];
                        acc[q][j] = mfma16(af, bb[ks], ks ? acc[q][j] : (f32x4){0.f, 0.f, 0.f, 0.f}); } }
                }
                if (st >= 4) { const int q = (st - 4) >> 2, el = (st - 4) & 3;
#pragma unroll
                    for (int j = 0; j < 2; ++j) { const int ch = 2 * q + j; if (ch < 9) {
                        if (ch == 0) { if (el < 2) pn[el] = fq == 0 ? acc[0][0][el] : 0.f; }
                        else { const int tk = (ch - 1) >> 2, mt = (ch - 1) & 3; pn[tk] = __builtin_fmaf(__builtin_fabsf(acc[q][j][el]), wv[tk][mt][el], pn[tk]); } } }
                }
                if (st == 20 && nt < 3) {
#pragma unroll
                    for (int k2 = 0; k2 < 4; ++k2) bb[k2] = *(const LAS bf16x8*)(cur + (16 * (nt + 1) + fr) * IX_PITCH + (4 * k2 + fq) * 16); }
                __builtin_amdgcn_sched_barrier(0);
            }
            p[0][nt] = pn[0]; p[1][nt] = pn[1];
        }
#pragma unroll
        for (int tk = 0; tk < 2; ++tk) {
            const float k0 = swapsum32(p[tk][0], p[tk][2]), k1 = swapsum32(p[tk][1], p[tk][3]);
            const float keep = swapsum16(k0, k1);
            SCo[(size_t)(mA + tk) * SEQ + 64 * g + lane] = keep; }
        if (g + 1 < ng) { LAS unsigned char* nx = lds + ((g + 1) & 1) * IX_BUF; *(LAS u32x4*)(nx + krow * IX_PITCH + kc * 16) = r0; *(LAS u32x4*)(nx + krow * IX_PITCH + kc * 16 + 16) = r1; }
        __syncthreads();
    }
}

__device__ __forceinline__ unsigned ord_key(float f) { const unsigned u = __builtin_bit_cast(unsigned, f); return u ^ ((u >> 31) ? 0xFFFFFFFFu : 0x80000000u); }
__device__ __forceinline__ int wave_sum_i(int v) {
    v += __builtin_amdgcn_update_dpp(0, v, 0xB1, 0xf, 0xf, false);
    v += __builtin_amdgcn_update_dpp(0, v, 0x4E, 0xf, 0xf, false);
    v += __builtin_amdgcn_update_dpp(0, v, 0x141, 0xf, 0xf, false);
    v += __builtin_amdgcn_update_dpp(0, v, 0x140, 0xf, 0xf, false);
    return __builtin_amdgcn_readlane(v, 0) + __builtin_amdgcn_readlane(v, 16) + __builtin_amdgcn_readlane(v, 32) + __builtin_amdgcn_readlane(v, 48);
}
__device__ __forceinline__ void topk_token(int m, const float* SCi, int* SEL, int lane) {
    const int t = m & (SEQ - 1), n = t + 1; int* sel = SEL + (size_t)m * 256;
    if (n <= 256) {
#pragma unroll
        for (int j = 0; j < 4; ++j) { const int i = lane + 64 * j; sel[i] = i < n ? i : -1; }
        return; }
    const float* sc = SCi + (size_t)m * SEQ;
    const int nq = (n + 255) >> 8;
    unsigned key[32][4];
    f32x4 raw[32];
#pragma unroll
    for (int j = 0; j < 32; ++j) raw[j] = *(const f32x4*)(sc + 256 * (j < nq ? j : 0) + 4 * lane);
#pragma unroll
    for (int j = 0; j < 32; ++j) { const int i0 = 256 * j + 4 * lane;
        key[j][0] = i0 < n ? ord_key(raw[j].x) : 0u; key[j][1] = i0 + 1 < n ? ord_key(raw[j].y) : 0u; key[j][2] = i0 + 2 < n ? ord_key(raw[j].z) : 0u; key[j][3] = i0 + 3 < n ? ord_key(raw[j].w) : 0u; }
    unsigned prefix = 0u;
#pragma unroll 1
    for (int bit = 31; bit >= 0; --bit) {
        const unsigned cand = prefix | (1u << bit); int cnt = 0; int cntv = 0;
#pragma unroll
        for (int jg = 0; jg < 4; ++jg) if (8 * jg < nq) {
#pragma unroll
            for (int j = 8 * jg; j < 8 * jg + 8; j += 2) {
                unsigned long long bm[5];
#pragma unroll
                for (int e = 0; e < 3; ++e) bm[e] = __ballot(key[j][e] >= cand);
                bm[3] = __ballot(key[j + 1][0] >= cand); bm[4] = __ballot(key[j + 1][1] >= cand);
                asm("v_cmp_le_u32 vcc, %1, %2\n\tv_addc_co_u32 %0, vcc, 0, %0, vcc" : "+v"(cntv) : "s"(cand), "v"(key[j][3]) : "vcc");
                asm("v_cmp_le_u32 vcc, %1, %2\n\tv_addc_co_u32 %0, vcc, 0, %0, vcc" : "+v"(cntv) : "s"(cand), "v"(key[j + 1][2]) : "vcc");
                asm("v_cmp_le_u32 vcc, %1, %2\n\tv_addc_co_u32 %0, vcc, 0, %0, vcc" : "+v"(cntv) : "s"(cand), "v"(key[j + 1][3]) : "vcc");
                __builtin_amdgcn_sched_barrier(0);
#pragma unroll
                for (int e = 0; e < 5; ++e) cnt += __builtin_popcountll(bm[e]);
                __builtin_amdgcn_sched_barrier(0); } }
        cnt += wave_sum_i(cntv);
        if (cnt >= 256) { prefix = cand; if (cnt == 256) break; }
    }
    const unsigned T = prefix;
    int cgts = 0;
#pragma unroll
    for (int jg = 0; jg < 4; ++jg) if (8 * jg < nq) {
#pragma unroll
        for (int j = 8 * jg; j < 8 * jg + 8; ++j)
#pragma unroll
            for (int e = 0; e < 4; ++e) cgts += __builtin_popcountll(__ballot(key[j][e] > T)); }
    const int want = 256 - cgts;
    int base = 0, eqtaken = 0;
    const unsigned long long ltmask = (1ull << lane) - 1ull;
#pragma unroll
    for (int j = 0; j < 32; ++j) if (j < nq) {
        const bool e0 = key[j][0] == T, e1 = key[j][1] == T, e2 = key[j][2] == T, e3 = key[j][3] == T;
        const int ecl = (int)e0 + (int)e1 + (int)e2 + (int)e3;
        const unsigned long long anyeq = __ballot(ecl != 0);
        int eqlow = 0, eqall = 0;
        if (anyeq) { int x = ecl;
#pragma unroll
            for (int off = 1; off < 64; off <<= 1) { const int y = __shfl_up(x, off); if (lane >= off) x += y; }
            eqlow = x - ecl; eqall = __shfl(x, 63); }
        const int r0 = eqtaken + eqlow;
        const bool t0 = key[j][0] > T || (e0 && r0 < want);
        const bool t1 = key[j][1] > T || (e1 && r0 + (int)e0 < want);
        const bool t2 = key[j][2] > T || (e2 && r0 + (int)e0 + (int)e1 < want);
        const bool t3 = key[j][3] > T || (e3 && r0 + (int)e0 + (int)e1 + (int)e2 < want);
        const unsigned long long b0 = __ballot(t0), b1 = __ballot(t1), b2 = __ballot(t2), b3 = __ballot(t3);
        const int i0 = 256 * j + 4 * lane; int pos = base + __builtin_popcountll(b0 & ltmask);
        if (t0 && pos < 256) sel[pos] = i0;
        base += __builtin_popcountll(b0); pos = base + __builtin_popcountll(b1 & ltmask);
        if (t1 && pos < 256) sel[pos] = i0 + 1;
        base += __builtin_popcountll(b1); pos = base + __builtin_popcountll(b2 & ltmask);
        if (t2 && pos < 256) sel[pos] = i0 + 2;
        base += __builtin_popcountll(b2); pos = base + __builtin_popcountll(b3 & ltmask);
        if (t3 && pos < 256) sel[pos] = i0 + 3;
        base += __builtin_popcountll(b3); eqtaken += eqall;
    }
}

template <int KSTEPS, int NB>
__device__ __forceinline__ void thin_gemm_wave(const bf16_t* A, size_t lda, const bf16_t* Bt, bf16_t* C, size_t ldc, int lane) {
    const int fr = lane & 15, fq = lane >> 4; constexpr int K = 32 * KSTEPS;
    bf16x8 a[2][KSTEPS];
#pragma unroll
    for (int mi = 0; mi < 2; ++mi)
#pragma unroll
        for (int ks = 0; ks < KSTEPS; ++ks) a[mi][ks] = *(const bf16x8*)(A + (size_t)(16 * mi + fr) * lda + 32 * ks + 8 * fq);
    for (int nt = 0; nt < NB * 4; ++nt) {
        f32x4 acc0 = (f32x4){0.f, 0.f, 0.f, 0.f}, acc1 = acc0;
        const bf16_t* bp = Bt + (size_t)(16 * nt + fr) * K + 8 * fq;
#pragma unroll
        for (int ks = 0; ks < KSTEPS; ++ks) { const bf16x8 bb = *(const bf16x8*)(bp + 32 * ks); acc0 = mfma16(bb, a[0][ks], acc0); acc1 = mfma16(bb, a[1][ks], acc1); }
        u32x2 w0, w1; w0.x = pk2(acc0[0], acc0[1]); w0.y = pk2(acc0[2], acc0[3]); w1.x = pk2(acc1[0], acc1[1]); w1.y = pk2(acc1[2], acc1[3]);
        *(u32x2*)(C + (size_t)fr * ldc + 16 * nt + 4 * fq) = w0; *(u32x2*)(C + (size_t)(16 + fr) * ldc + 16 * nt + 4 * fq) = w1;
    }
}

constexpr int AT_PITCH = 1056, AT_BUF = 32 * AT_PITCH, AT_QOFF = 2 * AT_BUF, AT_XOFF = AT_QOFF + 64 * AT_PITCH;
static_assert(AT_XOFF + 8192 <= MISC_OFF, "attention LDS map");
__device__ __forceinline__ void attn_q_dma(const bf16_t* QLAT, int m, LAS unsigned char* lds, int w, int lane) {
#pragma unroll
    for (int i = 0; i < 8; ++i) { const unsigned char* src = (const unsigned char*)QLAT + (size_t)m * 65536 + (8 * w + i) * 512 + lane * 4; LAS unsigned char* dst = lds + AT_QOFF + (8 * w + i) * AT_PITCH;
        __builtin_amdgcn_global_load_lds((const unsigned*)src, (LAS unsigned*)dst, 4, 0, 0); __builtin_amdgcn_global_load_lds((const unsigned*)(src + 256), (LAS unsigned*)(dst + 256), 4, 0, 0); }
}
__device__ __forceinline__ bf16x8 fp8x8_to_bf16(u32x2 r) {
    const auto a = __builtin_amdgcn_cvt_pk_f32_fp8((int)r.x, false), b2 = __builtin_amdgcn_cvt_pk_f32_fp8((int)r.x, true), c2 = __builtin_amdgcn_cvt_pk_f32_fp8((int)r.y, false), d = __builtin_amdgcn_cvt_pk_f32_fp8((int)r.y, true);
    u32x4 w; w.x = pg8::cvt_pk_bf16(a[0], a[1]); w.y = pg8::cvt_pk_bf16(b2[0], b2[1]); w.z = pg8::cvt_pk_bf16(c2[0], c2[1]); w.w = pg8::cvt_pk_bf16(d[0], d[1]);
    return __builtin_bit_cast(bf16x8, w);
}
__device__ __forceinline__ void attn_fetch32(u32x4 (&g)[4], int selreg, int half, int b, const bf16_t* CKV, int w, int lane) {
#pragma unroll
    for (int i = 0; i < 4; ++i) { const int idx = __builtin_amdgcn_readlane(selreg, 32 * half + 4 * w + i);
        g[i] = *(const u32x4*)(CKV + ((size_t)b * SEQ + idx) * 512 + lane * 8); }
}
__device__ __forceinline__ void attn_put32(const u32x4 (&g)[4], int bufi, LAS unsigned char* lds, int w, int lane) {
#pragma unroll
    for (int i = 0; i < 4; ++i) *(LAS u32x4*)(lds + bufi * AT_BUF + (4 * w + i) * AT_PITCH + lane * 16) = g[i];
}
__device__ __forceinline__ void attn_load_sel(int (&s)[4], int m, const int* SEL, int lane) {
    const int t = m & (SEQ - 1), n = (t + 1 < 256) ? t + 1 : 256;
#pragma unroll
    for (int j = 0; j < 4; ++j) { const int ki = 64 * j + lane; const int v = ki < n ? SEL[(size_t)m * 256 + ki] : 0; s[j] = ((unsigned)v < (unsigned)SEQ) ? v : 0; }
}
__device__ __forceinline__ void attn_stream(int blk, int G, bf16_t* QLAT, const bf16_t* CKV, const int* SEL, LAS unsigned char* lds, int tid) {
    const int lane = tid & 63, w = __builtin_amdgcn_readfirstlane(tid >> 6), fr = lane & 15, fq = lane >> 4;
    const int ht = w & 3, chalf = w >> 2;
    const bool xl = (G == 256); const int nT = xl ? 64 : (M - blk + G - 1) / G;
#define AT_TOK(i) (xl ? ((((i) >> 5) << 13) + ((blk & 7) << 10) + (((i) & 31) << 5) + (blk >> 3)) : (blk + (i) * G))
    int scur[4], snext[4];
    attn_load_sel(scur, AT_TOK(0), SEL, lane);
    if (nT > 1) attn_load_sel(snext, AT_TOK(1), SEL, lane); else { snext[0] = 0; snext[1] = 0; snext[2] = 0; snext[3] = 0; }
    bf16x8 qa[16];
    attn_q_dma(QLAT, AT_TOK(0), lds, w, lane);
    { u32x4 g0[4]; attn_fetch32(g0, scur[0], 0, AT_TOK(0) >> 13, CKV, w, lane); attn_put32(g0, 0, lds, w, lane); }
    asm volatile("s_waitcnt vmcnt(0)" ::: "memory");
    __syncthreads();
    const int ii = lane & 15, tq = ii >> 2, tp = ii & 3;
    for (int i = 0; i < nT; ++i) {
        const int m = AT_TOK(i), mn = AT_TOK(i + 1), t = m & (SEQ - 1), n = (t + 1 < 256) ? t + 1 : 256;
        const bool more = i + 1 < nT;
        f32x4 o[16];
#pragma unroll
        for (int c = 0; c < 16; ++c) o[c] = (f32x4){0.f, 0.f, 0.f, 0.f};
        float mrun = -3.0e38f, lrun = 0.f;
#pragma unroll
        for (int ks = 0; ks < 16; ++ks) qa[ks] = fp8x8_to_bf16(*(const LAS u32x2*)(lds + AT_QOFF + (16 * ht + fr) * AT_PITCH + 32 * ks + 8 * fq));
#pragma unroll
        for (int kb = 0; kb < 8; ++kb) {
            u32x4 g[4];
            if (kb == 1 && more) attn_q_dma(QLAT, mn, lds, w, lane);
            if (kb < 7) attn_fetch32(g, scur[(kb + 1) >> 1], (kb + 1) & 1, m >> 13, CKV, w, lane);
            else if (more) attn_fetch32(g, snext[0], 0, mn >> 13, CKV, w, lane);
            const LAS unsigned char* cur = lds + (kb & 1) * AT_BUF;
            if (32 * kb < n) {
                f32x4 own = (f32x4){0.f, 0.f, 0.f, 0.f};
                { bf16x8 cf[2][8];
#pragma unroll
                  for (int j = 0; j < 8; ++j) cf[0][j] = lfrag(cur, 16 * chalf + fr, AT_PITCH, 32 * j + 8 * fq);
#pragma unroll
                  for (int j = 0; j < 8; ++j) cf[1][j] = lfrag(cur, 16 * chalf + fr, AT_PITCH, 32 * (8 + j) + 8 * fq);
                  __builtin_amdgcn_sched_barrier(0);
#pragma unroll
                  for (int j = 0; j < 8; ++j) own = mfma16(cf[0][j], qa[j], own);
#pragma unroll
                  for (int j = 0; j < 8; ++j) own = mfma16(cf[1][j], qa[8 + j], own); }
                *(LAS f32x4*)(lds + AT_XOFF + (w * 64 + lane) * 16) = own;
                __syncthreads();
                const f32x4 oth = *(const LAS f32x4*)(lds + AT_XOFF + ((w ^ 4) * 64 + lane) * 16);
                f32x4 acc[2]; acc[0] = chalf == 0 ? own : oth; acc[1] = chalf == 0 ? oth : own;
                constexpr float KS = 0.08838834764831845f * 1.4426950408889634f / QL_SC;
                float mloc = -3.0e38f; const int lim = n - 32 * kb - 4 * fq;
                const bool full = n - 32 * kb >= 32;
                if (full) {
#pragma unroll
                    for (int km = 0; km < 2; ++km)
#pragma unroll
                        for (int r = 0; r < 4; ++r) { acc[km][r] *= KS; mloc = fmaxf(mloc, acc[km][r]); }
                } else {
#pragma unroll
                    for (int km = 0; km < 2; ++km)
#pragma unroll
                        for (int r = 0; r < 4; ++r) { const float sv = (16 * km + r) < lim ? acc[km][r] * KS : -3.0e38f; acc[km][r] = sv; mloc = fmaxf(mloc, sv); }
                }
                mloc = xmax_rows(mloc);
                const bool up = mloc > mrun + 11.0f;
                if (__any(up)) { const float mnew = up ? mloc : mrun, alpha = __builtin_amdgcn_exp2f(mrun - mnew); mrun = mnew; lrun *= alpha;
#pragma unroll
                    for (int c = 0; c < 16; ++c) o[c] = o[c] * alpha; }
                float ls = 0.f;
#pragma unroll
                for (int km = 0; km < 2; ++km)
#pragma unroll
                    for (int r = 0; r < 4; ++r) { const float pv = __builtin_amdgcn_exp2f(acc[km][r] - mrun); acc[km][r] = pv; ls += pv; }
                lrun += ls;
                const unsigned p0 = pg8::cvt_pk_bf16(acc[0][0], acc[0][1]), p1 = pg8::cvt_pk_bf16(acc[0][2], acc[0][3]), p2 = pg8::cvt_pk_bf16(acc[1][0], acc[1][1]), p3 = pg8::cvt_pk_bf16(acc[1][2], acc[1][3]);
                const bf16x8 pb = __builtin_bit_cast(bf16x8, (u32x4){p0, p1, p2, p3});
                const unsigned trb = (unsigned)(uintptr_t)(cur + (4 * fq + tq) * AT_PITCH + (256 * chalf + 4 * tp) * 2);
#define AT_TRRD(dst, off) asm volatile("ds_read_b64_tr_b16 %0, %1 offset:%2" : "=&v"(dst) : "v"(trb), "i"(off) : "memory")
#define AT_TRGRP(L, H, cg) do { AT_TRRD(L[0], 128 * (cg)); AT_TRRD(H[0], 128 * (cg) + 16 * AT_PITCH); AT_TRRD(L[1], 128 * (cg) + 32); AT_TRRD(H[1], 128 * (cg) + 32 + 16 * AT_PITCH); \
                    AT_TRRD(L[2], 128 * (cg) + 64); AT_TRRD(H[2], 128 * (cg) + 64 + 16 * AT_PITCH); AT_TRRD(L[3], 128 * (cg) + 96); AT_TRRD(H[3], 128 * (cg) + 96 + 16 * AT_PITCH); } while (0)
#define AT_TRWAIT(L, H, n) asm volatile("s_waitcnt lgkmcnt(" #n ")" : "+v"(L[0]), "+v"(L[1]), "+v"(L[2]), "+v"(L[3]), "+v"(H[0]), "+v"(H[1]), "+v"(H[2]), "+v"(H[3]) :: "memory")
#define AT_PVMMA(L, H, cg) do { _Pragma("unroll") for (int j = 0; j < 4; ++j) o[4 * (cg) + j] = mfma16((bf16x8){L[j][0], L[j][1], L[j][2], L[j][3], H[j][0], H[j][1], H[j][2], H[j][3]}, pb, o[4 * (cg) + j]); } while (0)
                { s16x4 la[4], ha[4], lb[4], hb[4];
                  AT_TRGRP(la, ha, 0); AT_TRGRP(lb, hb, 1);
                  AT_TRWAIT(la, ha, 8); __builtin_amdgcn_sched_barrier(0); AT_PVMMA(la, ha, 0); __builtin_amdgcn_sched_barrier(0);
                  AT_TRGRP(la, ha, 2);
                  AT_TRWAIT(lb, hb, 8); __builtin_amdgcn_sched_barrier(0); AT_PVMMA(lb, hb, 1); __builtin_amdgcn_sched_barrier(0);
                  AT_TRGRP(lb, hb, 3);
                  AT_TRWAIT(la, ha, 8); __builtin_amdgcn_sched_barrier(0); AT_PVMMA(la, ha, 2); __builtin_amdgcn_sched_barrier(0);
                  AT_TRWAIT(lb, hb, 0); __builtin_amdgcn_sched_barrier(0); AT_PVMMA(lb, hb, 3); }
#undef AT_TRGRP
#undef AT_TRWAIT
#undef AT_PVMMA
#undef AT_TRRD
            }
            if (kb == 7) {
                const float inv = OL_SC / xsum_rows(lrun);
                unsigned char* orow = (unsigned char*)QLAT + (size_t)m * 65536 + (16 * ht + fr) * 512 + 256 * chalf + 4 * fq;
#pragma unroll
                for (int tt = 0; tt < 16; ++tt) *(unsigned*)(orow + 16 * tt) = pack4_fp8(o[tt][0] * inv, o[tt][1] * inv, o[tt][2] * inv, o[tt][3] * inv);
                if (more) {
                    scur[0] = snext[0]; scur[1] = snext[1]; scur[2] = snext[2]; scur[3] = snext[3];
                    if (i + 2 < nT) attn_load_sel(snext, AT_TOK(i + 2), SEL, lane); }
            }
            if (kb < 7 || more) attn_put32(g, (kb + 1) & 1, lds, w, lane);
            __syncthreads();
        }
    }
#undef AT_TOK
}

#ifndef MK_ONE_LAUNCH
#define MK_ONE_LAUNCH 1
#endif
constexpr int NPH = 25;
struct Args { const float* in[20]; float* out; unsigned char* ws; int ph_lo, ph_hi; };

__global__ void __launch_bounds__(NTHR, 2) fwd(Args args) {
    extern __shared__ __attribute__((aligned(16))) unsigned char lds_raw[];
    LAS unsigned char* lds = (LAS unsigned char*)lds_raw;
    volatile LAS unsigned* MISC = (volatile LAS unsigned*)(lds + MISC_OFF);
    const int G = gridDim.x, blk = blockIdx.x, NGW = G * NWAVES;
    const int wave0 = __builtin_amdgcn_readfirstlane((int)threadIdx.x >> 6);
#define PH_IDS const int lane = hw_lane(), wave = wave0, tid = wave * 64 + lane, gw = blk * NWAVES + wave; (void)tid; (void)gw;
    unsigned char* ws = args.ws;
    unsigned* ctl = (unsigned*)(ws + WS_CTL);
    { PH_IDS for (int u = tid; u < (LDS_BYTES - MISC_OFF) / 4; u += NTHR) ((LAS unsigned*)(lds + MISC_OFF))[u] = 0u; }
    __syncthreads();
    XcdBarrier bar = xcd_barrier_post(ctl + CW_BAR, MISC + 8);
    const int lo = args.ph_lo, hi = args.ph_hi;
#define IN(k) (lo <= (k) && (k) < hi)
#define SEAM(k) do { if (IN(k) && IN((k) + 1)) xcd_barrier(bar, wave0 == 0 && hw_lane() == 0); } while (0)

    const float* x = args.in[0]; const float* g_mix = args.in[1]; const float* g_ffn = args.in[2]; const float* g_final = args.in[3];
    bf16_t* W_GLA_IN = (bf16_t*)(ws + WS_W_GLA_IN); bf16_t* W_GLA_O = (bf16_t*)(ws + WS_W_GLA_O); bf16_t* W_DSA_IN = (bf16_t*)(ws + WS_W_DSA_IN);
    bf16_t* W_QUP = (bf16_t*)(ws + WS_W_QUP); bf16_t* W_UK = (bf16_t*)(ws + WS_W_UK); bf16_t* W_UV = (bf16_t*)(ws + WS_W_UV); bf16_t* W_DSA_O = (bf16_t*)(ws + WS_W_DSA_O);
    bf16_t* W_UP = (bf16_t*)(ws + WS_W_UP); bf16_t* W_DN = (bf16_t*)(ws + WS_W_DN);
    bf16_t* H = (bf16_t*)(ws + WS_H); bf16_t* HN = (bf16_t*)(ws + WS_HN);

    if (IN(0)) { PH_IDS
        LAS float* scr = (LAS float*)(lds + wave * 16640);
        convert_matrix(args.in[4], 1, 4096, GLA_IN_N, GLA_IN_NP, W_GLA_IN, scr, gw, NGW, lane);
        rmsnorm_rows_bf16(x, g_mix, HN, gw, NGW, lane);
    }
    SEAM(0);
    if (IN(1)) { PH_IDS
        pg8::Gemm g{HN, W_GLA_IN, M, GLA_IN_NP, 4096}; pg8::StaticOrder S; S.init(M, GLA_IN_NP, G, blk);
        pg8::EpiGlaIn E{(bf16_t*)(ws + WS_GQ), (bf16_t*)(ws + WS_GK), (bf16_t*)(ws + WS_GV), (bf16_t*)(ws + WS_GR), (float*)(ws + WS_GA1)};
        pg8::gemm_phase<pg8::EpiGlaIn, pg8::StaticOrder, true, true>(lds, g, S, E, tid);
    }
    SEAM(1);
    if (IN(2)) { PH_IDS
        for (int u = blk; u < 2048; u += G)
            gla_pre_unit(u >> 3, u & 7, (bf16_t*)(ws + WS_GQ), (bf16_t*)(ws + WS_GK), (const float*)(ws + WS_GA1), args.in[5], args.in[6], (bf16_t*)(ws + WS_GKT), (float*)(ws + WS_GEBL), (LAS float*)lds, tid);
    }
    SEAM(2);
    if (IN(3)) { PH_IDS
        if (G >= 256) {
            if (blk < 128) gla_scan_unit(blk >> 6, (blk >> 3) & 7, blk & 7, (const bf16_t*)(ws + WS_GQ), (const bf16_t*)(ws + WS_GK), (const bf16_t*)(ws + WS_GKT), (const bf16_t*)(ws + WS_GV), (const float*)(ws + WS_GEBL), (bf16_t*)(ws + WS_GORAW), lds, tid);
            else { LAS float* scr = (LAS float*)(lds + wave * 16640); const int cgw = (blk - 128) * NWAVES + wave, CNGW = (G - 128) * NWAVES;
        convert_matrix(args.in[8], 1, 4096, 4096, 4096, W_GLA_O, scr, cgw, CNGW, lane);
        convert_matrix(args.in[9], 1, 4096, DSA_IN_N, DSA_IN_NP, W_DSA_IN, scr, cgw, CNGW, lane);
        convert_matrix(args.in[12], 1, 1024, 16384, 16384, W_QUP, scr, cgw, CNGW, lane);
        convert_matrix(args.in[13], 64, 128, 512, 512, W_UK, scr, cgw, CNGW, lane);
        convert_matrix<false, true>(args.in[14], 64, 512, 128, 128, W_UV, scr, cgw, CNGW, lane, WUV_SC);
        convert_matrix<false, true>(args.in[15], 1, 8192, 4096, 4096, W_DSA_O, scr, cgw, CNGW, lane, WO_SC);
        convert_matrix<true>(args.in[16], 1, 4096, DFF2, DFF2, W_UP, scr, cgw, CNGW, lane);
        convert_matrix<true, true>(args.in[16] + (size_t)4096 * DFF2, 1, 4096, DFF2, DFF2, W_UP + (size_t)DFF2 * 4096, scr, cgw, CNGW, lane, WUP_SC);
        convert_matrix(args.in[19], 1, DFF, 4096, 4096, W_DN, scr, cgw, CNGW, lane);
        convert_matrix<false, true>(args.in[19] + (size_t)DFF * 4096, 1, DFF, 4096, 4096, W_DN + (size_t)4096 * DFF, scr, cgw, CNGW, lane, WDN_SC);
            }
        } else {
            for (int u = blk; u < 128; u += G)
                gla_scan_unit(u >> 6, (u >> 3) & 7, u & 7, (const bf16_t*)(ws + WS_GQ), (const bf16_t*)(ws + WS_GK), (const bf16_t*)(ws + WS_GKT), (const bf16_t*)(ws + WS_GV), (const float*)(ws + WS_GEBL), (bf16_t*)(ws + WS_GORAW), lds, tid);
            { LAS float* scr = (LAS float*)(lds + wave * 16640); const int cgw = gw, CNGW = NGW;
        convert_matrix(args.in[8], 1, 4096, 4096, 4096, W_GLA_O, scr, cgw, CNGW, lane);
        convert_matrix(args.in[9], 1, 4096, DSA_IN_N, DSA_IN_NP, W_DSA_IN, scr, cgw, CNGW, lane);
        convert_matrix(args.in[12], 1, 1024, 16384, 16384, W_QUP, scr, cgw, CNGW, lane);
        convert_matrix(args.in[13], 64, 128, 512, 512, W_UK, scr, cgw, CNGW, lane);
        convert_matrix<false, true>(args.in[14], 64, 512, 128, 128, W_UV, scr, cgw, CNGW, lane, WUV_SC);
        convert_matrix<false, true>(args.in[15], 1, 8192, 4096, 4096, W_DSA_O, scr, cgw, CNGW, lane, WO_SC);
        convert_matrix<true>(args.in[16], 1, 4096, DFF2, DFF2, W_UP, scr, cgw, CNGW, lane);
        convert_matrix<true, true>(args.in[16] + (size_t)4096 * DFF2, 1, 4096, DFF2, DFF2, W_UP + (size_t)DFF2 * 4096, scr, cgw, CNGW, lane, WUP_SC);
        convert_matrix(args.in[19], 1, DFF, 4096, 4096, W_DN, scr, cgw, CNGW, lane);
        convert_matrix<false, true>(args.in[19] + (size_t)DFF * 4096, 1, DFF, 4096, 4096, W_DN + (size_t)4096 * DFF, scr, cgw, CNGW, lane, WDN_SC);
            }
        }
    }
    SEAM(3);
    if (IN(4)) { PH_IDS gla_out_norm((const bf16_t*)(ws + WS_GORAW), (const bf16_t*)(ws + WS_GR), args.in[7], (bf16_t*)(ws + WS_GOG), gw, NGW, lane); }
    SEAM(4);
    if (IN(5)) { PH_IDS
        pg8::Gemm g{(const bf16_t*)(ws + WS_GOG), W_GLA_O, M, 4096, 4096}; pg8::StaticOrder S; S.init(M, 4096, G, blk);
        pg8::EpiResBf16<true> E{x, H, 4096};
        pg8::gemm_phase<pg8::EpiResBf16<true>, pg8::StaticOrder, true, true>(lds, g, S, E, tid);
    }
    SEAM(5);
    if (IN(6)) { PH_IDS rmsnorm_rows_from_bf16<false>(H, g_ffn, HN, gw, NGW, lane); }
    SEAM(6);
    if (IN(7)) { PH_IDS
        pg8::Gemm g{HN, W_UP, M, DFF2, 4096}; pg8::StaticOrder S; S.init(M, DFF2, G, blk);
        pg8::EpiConvAct<false> E{(bf16_t*)(ws + WS_ACT), (bf16_t*)(ws + WS_U), args.in[17], args.in[18]};
        pg8::gemm_phase<pg8::EpiConvAct<false>, pg8::StaticOrder, true, true>(lds, g, S, E, tid);
    }
    SEAM(7);
    if (IN(8)) { PH_IDS conv_fixup<false>((const bf16_t*)(ws + WS_U), args.in[17], args.in[18], (bf16_t*)(ws + WS_ACT), blk * NTHR + tid, G * NTHR); }
    SEAM(8);
    if (IN(9)) { PH_IDS
        pg8::Gemm g{(const bf16_t*)(ws + WS_ACT), W_DN, M, 4096, DFF, 0}; pg8::StaticOrder S; S.init(M, 4096, G, blk);
        pg8::EpiResBf16<false> E{H, H, 4096};
        pg8::gemm_phase<pg8::EpiResBf16<false>, pg8::StaticOrder, true, true>(lds, g, S, E, tid);
    }
    SEAM(9);
    if (IN(10)) { PH_IDS rmsnorm_rows_from_bf16<false>(H, g_mix + D, HN, gw, NGW, lane); }
    SEAM(10);
    if (IN(11)) { PH_IDS
        pg8::Gemm g{HN, W_DSA_IN, M, DSA_IN_NP, 4096}; pg8::StaticOrder S; S.init(M, DSA_IN_NP, G, blk);
        pg8::EpiF32 E{(float*)(ws + WS_Z), DSA_IN_NP};
        pg8::gemm_phase<pg8::EpiF32, pg8::StaticOrder, true, true>(lds, g, S, E, tid);
    }
    SEAM(11);
    if (IN(12)) { PH_IDS dsa_norm((const float*)(ws + WS_Z), args.in[10], args.in[11], (bf16_t*)(ws + WS_CQN), (bf16_t*)(ws + WS_CKV), (bf16_t*)(ws + WS_KIDX), (float*)(ws + WS_WIDX), gw, NGW, lane); }
    SEAM(12);
    if (IN(13)) { PH_IDS
        pg8::Gemm g{(const bf16_t*)(ws + WS_CQN), W_QUP, M, 16384, 1024}; pg8::StaticOrder S; S.init(M, 16384, G, blk);
        pg8::EpiBf16Split E{(bf16_t*)(ws + WS_QATT), 8192, 8192, (size_t)(WS_QIDX - WS_QATT) / 2};
        pg8::gemm_phase<pg8::EpiBf16Split, pg8::StaticOrder, true, true>(lds, g, S, E, tid);
    }
    SEAM(13);
    if (IN(14)) { PH_IDS
        for (int i = 0; i * G < 1024; ++i) { const int u = i * G + ((i & 1) ? (G - 1 - blk) : blk); if (u < 1024) indexer_group(u, (const bf16_t*)(ws + WS_QIDX), (const bf16_t*)(ws + WS_KIDX), (const float*)(ws + WS_WIDX), (float*)(ws + WS_SC), lds, tid); }
        asm volatile("s_waitcnt vmcnt(0)" ::: "memory");
        for (int i = 0; i * G < 1024; ++i) { const int u = i * G + ((i & 1) ? (G - 1 - blk) : blk); if (u < 1024) {
#pragma unroll 1
            for (int tk = 0; tk < 2; ++tk) topk_token(16 * u + 2 * wave + tk, (const float*)(ws + WS_SC), (int*)(ws + WS_SEL), lane); } }
    }
    SEAM(15);
    if (IN(16)) { PH_IDS
        pg8::Gemm g{(const bf16_t*)(ws + WS_QATT), W_UK, M, 32768, 128, 8192}; pg8::StaticOrder S; S.init(M, 32768, G, blk);
        pg8::EpiQLat8 E{(unsigned char*)(ws + WS_QLAT), QL_SC};
        pg8::gemm_phase<pg8::EpiQLat8, pg8::StaticOrder, true, true, 1>(lds, g, S, E, tid);
    }
    SEAM(16);
    if (IN(17)) { PH_IDS
        attn_stream(blk, G, (bf16_t*)(ws + WS_QLAT), (const bf16_t*)(ws + WS_CKV), (const int*)(ws + WS_SEL), lds, tid);
    }
    SEAM(17);
    if (IN(18)) { PH_IDS
        pg8::Gemm g{(const bf16_t*)(ws + WS_QLAT), W_UV, M, 8192, 256, 32768}; pg8::StaticOrder S; S.init(128 * 256, 32 * 256, G, blk);
        pg8::EpiDiag<true> E{(bf16_t*)(ws + WS_QATT), 8192, DSO_SC / (OL_SC * WUV_SC)};
        pg8::gemm_phase<pg8::EpiDiag<true>, pg8::StaticOrder, true, true, 2, true>(lds, g, S, E, tid);
    }
    SEAM(18);
    if (IN(19)) { PH_IDS
        pg8::Gemm g{(const bf16_t*)(ws + WS_QATT), W_DSA_O, M, 4096, 4096}; pg8::StaticOrder S; S.init(M, 4096, G, blk);
        pg8::EpiResBf16<false, DSAO_SH> E{H, H, 4096};
        pg8::gemm_phase<pg8::EpiResBf16<false, DSAO_SH>, pg8::StaticOrder, true, true, 0, true>(lds, g, S, E, tid);
    }
    SEAM(19);
    if (IN(20)) { PH_IDS rmsnorm_rows_from_bf16<2>(H, g_ffn + D, HN, gw, NGW, lane); }
    SEAM(20);
    if (IN(21)) { PH_IDS
        pg8::Gemm g{HN, W_UP + (size_t)DFF2 * 4096, M, DFF2, 2048}; pg8::StaticOrder S; S.init(M, DFF2, G, blk);
        pg8::EpiConvAct<true, UP_SH> E{(bf16_t*)(ws + WS_ACT), (bf16_t*)(ws + WS_U), args.in[17] + (size_t)3 * DFF2, args.in[18] + DFF2};
        pg8::gemm_phase<pg8::EpiConvAct<true, UP_SH>, pg8::StaticOrder, true, true, 0, true>(lds, g, S, E, tid);
    }
    SEAM(21);
    if (IN(22)) { PH_IDS conv_fixup<true>((const bf16_t*)(ws + WS_U), args.in[17] + (size_t)3 * DFF2, args.in[18] + DFF2, (bf16_t*)(ws + WS_ACT), blk * NTHR + tid, G * NTHR); }
    SEAM(22);
    if (IN(23)) { PH_IDS
        pg8::Gemm g{(const bf16_t*)(ws + WS_ACT), W_DN + (size_t)4096 * DFF, M, 4096, DFF / 2, 0}; pg8::StaticOrder S; S.init(M, 4096, G, blk);
        pg8::EpiResBf16<false, DN_SH> E{H, H, 4096};
        pg8::gemm_phase<pg8::EpiResBf16<false, DN_SH>, pg8::StaticOrder, true, true, 0, true>(lds, g, S, E, tid);
    }
    SEAM(23);
    if (IN(24)) { PH_IDS rmsnorm_rows_from_bf16<true>(H, g_final, args.out, gw, NGW, lane); }
#undef IN
#undef SEAM
}

extern "C" void kernel_launch(void* const* d_in, const int* in_sizes, int n_in, void* d_out, int out_size, void* d_ws, size_t ws_size, hipStream_t stream) {
    static int grid = 0;
    if (grid == 0) {
        if (n_in != 20 || in_sizes[0] != M * D || out_size != M * D || ws_size < WS_END) { fprintf(stderr, "kernel_launch: unexpected shapes / workspace (n_in %d, ws %zu < %zu); nothing launched\n", n_in, ws_size, (size_t)WS_END); grid = -1; return; }
        int dev = 0, cus = 0, per_cu = 0;
        if (hipGetDevice(&dev) != hipSuccess || hipDeviceGetAttribute(&cus, hipDeviceAttributeMultiprocessorCount, dev) != hipSuccess) { grid = -1; return; }
        if (hipFuncSetAttribute((const void*)fwd, hipFuncAttributeMaxDynamicSharedMemorySize, LDS_BYTES) != hipSuccess) { fprintf(stderr, "kernel_launch: hipFuncSetAttribute failed\n"); grid = -1; return; }
        if (hipOccupancyMaxActiveBlocksPerMultiprocessor(&per_cu, (const void*)fwd, NTHR, LDS_BYTES) != hipSuccess || per_cu < 1) { fprintf(stderr, "kernel_launch: occupancy query says %d blocks per CU\n", per_cu); }
        (void)hipGetLastError();
        grid = cus;
    }
    if (grid < 0) return;
    if (hipMemsetAsync((char*)d_ws + WS_CTL, 0, CTL_ZERO_BYTES, stream) != hipSuccess) return;
    Args a{};
    for (int i = 0; i < 20; ++i) a.in[i] = (const float*)d_in[i];
    a.out = (float*)d_out; a.ws = (unsigned char*)d_ws;
#if MK_ONE_LAUNCH
    a.ph_lo = 0; a.ph_hi = NPH;
    hipLaunchKernelGGL(fwd, dim3(grid), dim3(NTHR), LDS_BYTES, stream, a);
#else
    for (int p = 0; p < NPH; ++p) { a.ph_lo = p; a.ph_hi = p + 1; hipLaunchKernelGGL(fwd, dim3(grid), dim3(NTHR), LDS_BYTES, stream, a); }
#endif
}
```

```cpp
#include <hip/hip_runtime.h>
#include <stdint.h>
#include <stdio.h>

#define GAS __attribute__((address_space(1)))
#define LAS __attribute__((address_space(3)))
typedef unsigned short bf16_t;
typedef short bf16x8 __attribute__((ext_vector_type(8)));
typedef short s16x4 __attribute__((ext_vector_type(4)));
typedef float f32x4 __attribute__((ext_vector_type(4)));
typedef unsigned u32x4 __attribute__((ext_vector_type(4)));
typedef unsigned u32x2 __attribute__((ext_vector_type(2)));

namespace pg8 {
#define PG8_LAS __attribute__((address_space(3)))
typedef unsigned short bf16_t;
typedef short bf16x8 __attribute__((ext_vector_type(8)));
typedef float f32x4 __attribute__((ext_vector_type(4)));
typedef unsigned u32x4 __attribute__((ext_vector_type(4)));
constexpr int BM = 256, BK = 64, HALF = 128, HTB = HALF * BK * 2  , STAGE_BYTES = 8 * HTB, NXCD = 8, WGM = 8;

__host__ __device__ __forceinline__ int lds_byte(int r, int c) { const int st = (r >> 4) * 2 + (c >> 5), rr = r & 15, cc = c & 31, ob = rr * 64 + cc * 2; return st * 1024 + (ob ^ (((ob >> 9) & 1) << 5)); }
__host__ __device__ __forceinline__ void stage_rc(int b, int& R, int& C) { const int st = b / 1024, sb = b % 1024, swz = sb ^ (((sb >> 9) & 1) << 5); R = (st >> 1) * 16 + swz / 64; C = (st & 1) * 32 + (swz % 64) / 2; }
__host__ __device__ __forceinline__ int perm32(int rho) { const int n = rho >> 4, i = rho & 15; return 8 * (i >> 2) + 4 * n + (i & 3); }

struct Unit { int pm, pn; };
typedef int v4i_t __attribute__((ext_vector_type(4))); typedef int v8i_t __attribute__((ext_vector_type(8)));
struct Gemm { const bf16_t* A; const bf16_t* Bt; int M, N, K; int lda; };

struct StaticOrder {
    int nM, nN, nwg, G, c;
    __host__ __device__ void init(int M, int N, int G_, int c_) { nM = M / BM; nN = N / BM; nwg = nM * nN; G = G_; c = c_; }
    __host__ __device__ bool next(int i, Unit& u) const {
        const long L = (long)i * G + c; if (L >= nwg) return false;
        int wgid = (int)L; { const int q = nwg / NXCD, r = nwg % NXCD, xcd = wgid % NXCD, off = wgid / NXCD; wgid = (xcd < r ? xcd * (q + 1) : r * (q + 1) + (xcd - r) * q) + off; }
        const int nig = WGM * nN, gid = wgid / nig, fm = gid * WGM, gsz = (nM - fm) < WGM ? (nM - fm) : WGM;
        u.pm = fm + ((wgid % nig) % gsz); u.pn = (wgid % nig) / gsz; return true;
    }
    __device__ __forceinline__ void a_ready(const Unit&) const {}
    __device__ __forceinline__ void done(const Unit&) const {}
};
__device__ __forceinline__ unsigned cvt_pk_bf16(float lo, float hi) { unsigned r; asm volatile("v_cvt_pk_bf16_f32 %0, %1, %2" : "=v"(r) : "v"(lo), "v"(hi)); return r; }

template <int SH = 0> struct EpiBf16Split {
    static constexpr bool PERM = true, AFTER_DRAIN = false, LDS_PRE = false;
    bf16_t* O; int ldc; int split_cols; size_t split_stride;
    __device__ __forceinline__ void operator()(const f32x4 (&acc)[2][2][4][2], const Unit& u, int wr, int wc, int fr, int fq) const {
        const int row0 = u.pm * BM + wr * 64 + fr; int colt = u.pn * BM; bf16_t* base = O;
        if (split_cols) { const int t = colt / split_cols; base += (size_t)t * split_stride; colt -= t * split_cols; }
        const int col0 = colt + wc * 32 + 8 * fq;
#pragma unroll
        for (int ai = 0; ai < 2; ++ai)
#pragma unroll
            for (int m = 0; m < 4; ++m) { bf16_t* rowp = base + (size_t)(row0 + ai * HALF + m * 16) * ldc + col0;
#pragma unroll
                for (int bj = 0; bj < 2; ++bj) { constexpr float sc = 1.0f / (float)(1 << SH); const f32x4 v0 = SH ? acc[ai][bj][m][0] * sc : acc[ai][bj][m][0], v1 = SH ? acc[ai][bj][m][1] * sc : acc[ai][bj][m][1];
                    u32x4 w; w.x = cvt_pk_bf16(v0[0], v0[1]); w.y = cvt_pk_bf16(v0[2], v0[3]); w.z = cvt_pk_bf16(v1[0], v1[1]); w.w = cvt_pk_bf16(v1[2], v1[3]);
                    *(u32x4*)(rowp + bj * HALF) = w; } }
    }
};
struct EpiF32 {
    static constexpr bool PERM = false, AFTER_DRAIN = false, LDS_PRE = false;
    float* C; int ldc;
    __device__ __forceinline__ void operator()(const f32x4 (&acc)[2][2][4][2], const Unit& u, int wr, int wc, int fr, int fq) const {
        const int row0 = u.pm * BM + wr * 64 + fr, col0 = u.pn * BM + wc * 32 + 4 * fq;
#pragma unroll
        for (int ai = 0; ai < 2; ++ai)
#pragma unroll
            for (int m = 0; m < 4; ++m) { float* rowp = C + (size_t)(row0 + ai * HALF + m * 16) * ldc + col0;
#pragma unroll
                for (int bj = 0; bj < 2; ++bj)
#pragma unroll
                    for (int n = 0; n < 2; ++n) *(f32x4*)(rowp + bj * HALF + n * 16) = acc[ai][bj][m][n]; }
    }
};
struct EpiResF32 {
    static constexpr bool PERM = false, AFTER_DRAIN = false, LDS_PRE = false;
    const float* R; float* C; int ldc;
    __device__ __forceinline__ void operator()(const f32x4 (&acc)[2][2][4][2], const Unit& u, int wr, int wc, int fr, int fq) const {
        const int row0 = u.pm * BM + wr * 64 + fr, col0 = u.pn * BM + wc * 32 + 4 * fq;
#pragma unroll
        for (int ai = 0; ai < 2; ++ai)
#pragma unroll
            for (int m = 0; m < 4; ++m) { const size_t off = (size_t)(row0 + ai * HALF + m * 16) * ldc + col0;
                f32x4 rv[2][2];
#pragma unroll
                for (int bj = 0; bj < 2; ++bj)
#pragma unroll
                    for (int n = 0; n < 2; ++n) rv[bj][n] = *(const f32x4*)(R + off + bj * HALF + n * 16);
#pragma unroll
                for (int bj = 0; bj < 2; ++bj)
#pragma unroll
                    for (int n = 0; n < 2; ++n) *(f32x4*)(C + off + bj * HALF + n * 16) = rv[bj][n] + acc[ai][bj][m][n];
                if (m & 1) asm volatile("" ::: "memory"); }
    }
};
template <bool RF32, int SH = 0> struct EpiResBf16 {
    static constexpr bool PERM = true, AFTER_DRAIN = false, LDS_PRE = false;
    const void* R; bf16_t* HB; int ldc;
    __device__ __forceinline__ void operator()(const f32x4 (&acc)[2][2][4][2], const Unit& u, int wr, int wc, int fr, int fq) const {
        const int row0 = u.pm * BM + wr * 64 + fr, col0 = u.pn * BM + wc * 32 + 8 * fq;
        if constexpr (!RF32) {
            u32x4 rw[2][4][2];
#pragma unroll
            for (int ai = 0; ai < 2; ++ai)
#pragma unroll
                for (int m = 0; m < 4; ++m)
#pragma unroll
                    for (int bj = 0; bj < 2; ++bj) rw[ai][m][bj] = *(const u32x4*)((const bf16_t*)R + (size_t)(row0 + ai * HALF + m * 16) * ldc + col0 + bj * HALF);
            asm volatile("" ::: "memory");
#pragma unroll
            for (int ai = 0; ai < 2; ++ai)
#pragma unroll
                for (int m = 0; m < 4; ++m) { const size_t off = (size_t)(row0 + ai * HALF + m * 16) * ldc + col0;
#pragma unroll
                    for (int bj = 0; bj < 2; ++bj) { const u32x4 w0 = rw[ai][m][bj]; constexpr float sc = 1.0f / (float)(1 << SH);
                        const f32x4 r0 = (f32x4){__builtin_bit_cast(float, w0.x << 16), __builtin_bit_cast(float, w0.x & 0xffff0000u), __builtin_bit_cast(float, w0.y << 16), __builtin_bit_cast(float, w0.y & 0xffff0000u)};
                        const f32x4 r1 = (f32x4){__builtin_bit_cast(float, w0.z << 16), __builtin_bit_cast(float, w0.z & 0xffff0000u), __builtin_bit_cast(float, w0.w << 16), __builtin_bit_cast(float, w0.w & 0xffff0000u)};
                        const f32x4 v0 = SH ? r0 + acc[ai][bj][m][0] * sc : r0 + acc[ai][bj][m][0], v1 = SH ? r1 + acc[ai][bj][m][1] * sc : r1 + acc[ai][bj][m][1];
                        u32x4 w; w.x = cvt_pk_bf16(v0[0], v0[1]); w.y = cvt_pk_bf16(v0[2], v0[3]); w.z = cvt_pk_bf16(v1[0], v1[1]); w.w = cvt_pk_bf16(v1[2], v1[3]);
                        *(u32x4*)(HB + off + bj * HALF) = w; } }
        } else {
#pragma unroll
        for (int ai = 0; ai < 2; ++ai)
#pragma unroll
            for (int m = 0; m < 4; ++m) { const size_t off = (size_t)(row0 + ai * HALF + m * 16) * ldc + col0;
                f32x4 r0[2], r1[2];
#pragma unroll
                for (int bj = 0; bj < 2; ++bj) { r0[bj] = *(const f32x4*)((const float*)R + off + bj * HALF); r1[bj] = *(const f32x4*)((const float*)R + off + bj * HALF + 4); }
#pragma unroll
                for (int bj = 0; bj < 2; ++bj) { constexpr float sc = 1.0f / (float)(1 << SH); const f32x4 v0 = SH ? r0[bj] + acc[ai][bj][m][0] * sc : r0[bj] + acc[ai][bj][m][0], v1 = SH ? r1[bj] + acc[ai][bj][m][1] * sc : r1[bj] + acc[ai][bj][m][1];
                    u32x4 w; w.x = cvt_pk_bf16(v0[0], v0[1]); w.y = cvt_pk_bf16(v0[2], v0[3]); w.z = cvt_pk_bf16(v1[0], v1[1]); w.w = cvt_pk_bf16(v1[2], v1[3]);
                    *(u32x4*)(HB + off + bj * HALF) = w; }
                if (m & 1) asm volatile("" ::: "memory"); }
        }
    }
};
struct EpiGlaIn {
    static constexpr bool PERM = true, AFTER_DRAIN = false, LDS_PRE = false;
    bf16_t *Q, *K, *V, *Rg; float* A1;
    __device__ __forceinline__ void operator()(const f32x4 (&acc)[2][2][4][2], const Unit& u, int wr, int wc, int fr, int fq) const {
        const int row0 = u.pm * BM + wr * 64 + fr; const int colt = u.pn * BM;
        if (u.pn < 48) {
            bf16_t* base; int ldc, c0;
            if (colt < 2048) { base = Q; ldc = 2048; c0 = colt; }
            else if (colt < 4096) { base = K; ldc = 2048; c0 = colt - 2048; }
            else if (colt < 8192) { base = V; ldc = 4096; c0 = colt - 4096; }
            else { base = Rg; ldc = 4096; c0 = colt - 8192; }
            const int col0 = c0 + wc * 32 + 8 * fq;
#pragma unroll
            for (int ai = 0; ai < 2; ++ai)
#pragma unroll
                for (int m = 0; m < 4; ++m) { bf16_t* rowp = base + (size_t)(row0 + ai * HALF + m * 16) * ldc + col0;
#pragma unroll
                    for (int bj = 0; bj < 2; ++bj) { const f32x4 v0 = acc[ai][bj][m][0], v1 = acc[ai][bj][m][1];
                        u32x4 w; w.x = cvt_pk_bf16(v0[0], v0[1]); w.y = cvt_pk_bf16(v0[2], v0[3]); w.z = cvt_pk_bf16(v1[0], v1[1]); w.w = cvt_pk_bf16(v1[2], v1[3]);
                        *(u32x4*)(rowp + bj * HALF) = w; } }
        } else if (wc == 0 && fq < 2) {
#pragma unroll
            for (int ai = 0; ai < 2; ++ai)
#pragma unroll
                for (int m = 0; m < 4; ++m) { float* p = A1 + (size_t)(row0 + ai * HALF + m * 16) * 16 + 8 * fq;
                    *(f32x4*)p = acc[ai][0][m][0]; *(f32x4*)(p + 4) = acc[ai][0][m][1]; }
        }
    }
};

__device__ __forceinline__ unsigned pack4_fp8_e(float a, float b, float c2, float d) {
    a = __builtin_amdgcn_fmed3f(a, -448.f, 448.f); b = __builtin_amdgcn_fmed3f(b, -448.f, 448.f); c2 = __builtin_amdgcn_fmed3f(c2, -448.f, 448.f); d = __builtin_amdgcn_fmed3f(d, -448.f, 448.f);
    unsigned p; asm volatile("v_cvt_pk_fp8_f32 %0, %1, %2" : "=v"(p) : "v"(a), "v"(b)); asm volatile("v_cvt_pk_fp8_f32 %0, %1, %2 op_sel:[0,0,1]" : "+v"(p) : "v"(c2), "v"(d)); return p; }
template <bool O8 = false> struct EpiDiag {
    static constexpr bool PERM = true, AFTER_DRAIN = false, LDS_PRE = false;
    bf16_t* O; int ldc; float osc;
    __device__ __forceinline__ void operator()(const f32x4 (&acc)[2][2][4][2], const Unit& u, int wr, int wc, int fr, int fq) const {
        const int row0 = u.pm * HALF + wr * 64 + fr, col0 = u.pn * BM + wc * 32 + 8 * fq;
#pragma unroll
        for (int ai = 0; ai < 2; ++ai)
#pragma unroll
            for (int m = 0; m < 4; ++m) { bf16_t* rowp = O + (size_t)(row0 + m * 16) * ldc + col0 + ai * HALF;
                const f32x4 v0 = acc[ai][ai][m][0], v1 = acc[ai][ai][m][1];
                if (O8) { u32x2 w; w.x = pack4_fp8_e(v0[0] * osc, v0[1] * osc, v0[2] * osc, v0[3] * osc); w.y = pack4_fp8_e(v1[0] * osc, v1[1] * osc, v1[2] * osc, v1[3] * osc);
                    *(u32x2*)((unsigned char*)O + (size_t)(row0 + m * 16) * ldc + col0 + ai * HALF) = w; }
                else { u32x4 w; w.x = cvt_pk_bf16(v0[0], v0[1]); w.y = cvt_pk_bf16(v0[2], v0[3]); w.z = cvt_pk_bf16(v1[0], v1[1]); w.w = cvt_pk_bf16(v1[2], v1[3]);
                    *(u32x4*)rowp = w; } }
    }
};

__device__ __forceinline__ float dpp_ror1f(float x) { return __builtin_bit_cast(float, __builtin_amdgcn_mov_dpp(__builtin_bit_cast(int, x), 0x121, 0xf, 0xf, false)); }
__device__ __forceinline__ float dpp_ror2f(float x) { return __builtin_bit_cast(float, __builtin_amdgcn_mov_dpp(__builtin_bit_cast(int, x), 0x122, 0xf, 0xf, false)); }
__device__ __forceinline__ f32x4 dpp_ror1(f32x4 v) { return (f32x4){dpp_ror1f(v.x), dpp_ror1f(v.y), dpp_ror1f(v.z), dpp_ror1f(v.w)}; }
__device__ __forceinline__ f32x4 dpp_ror2(f32x4 v) { return (f32x4){dpp_ror2f(v.x), dpp_ror2f(v.y), dpp_ror2f(v.z), dpp_ror2f(v.w)}; }
struct EpiQLat8 {
    static constexpr bool PERM = true, AFTER_DRAIN = false, LDS_PRE = false;
    unsigned char* O; float sc;
    __device__ __forceinline__ void operator()(const f32x4 (&acc)[2][2][4][2], const Unit& u, int wr, int wc, int fr, int fq) const {
        const int row0 = u.pm * BM + wr * 64 + fr, col0 = u.pn * BM + wc * 32 + 8 * fq;
#pragma unroll
        for (int ai = 0; ai < 2; ++ai)
#pragma unroll
            for (int m = 0; m < 4; ++m) { unsigned char* rowp = O + (size_t)(row0 + ai * HALF + m * 16) * 65536 + col0;
#pragma unroll
                for (int bj = 0; bj < 2; ++bj) { const f32x4 v0 = acc[ai][bj][m][0] * sc, v1 = acc[ai][bj][m][1] * sc;
                    u32x2 w; w.x = pack4_fp8_e(v0[0], v0[1], v0[2], v0[3]); w.y = pack4_fp8_e(v1[0], v1[1], v1[2], v1[3]);
                    *(u32x2*)(rowp + bj * HALF) = w; } }
    }
};
template <bool F8OUT = true, int ASH = 0> struct EpiConvAct {
    static constexpr bool PERM = true, AFTER_DRAIN = false, LDS_PRE = true;
    static constexpr int CONV_LDS = STAGE_BYTES;
    bf16_t* ACT; bf16_t* UH; const float* cw; const float* cb;
    __device__ __forceinline__ void prefetch(const Unit& u, PG8_LAS unsigned char* lds, int wid, int lane, int buf) const {
        constexpr int DFFc = 11008, DFF2c = 22016;
        const int arr = wid >> 1, isup = wid & 1;
        const float* src = (arr < 3 ? cw + (size_t)arr * DFF2c : cb) + (isup ? DFFc : 0) + u.pn * HALF;
        PG8_LAS unsigned char* dst = lds + CONV_LDS + buf * 4096 + wid * 512;
        __builtin_amdgcn_global_load_lds((const unsigned*)(src + lane), (PG8_LAS unsigned*)dst, 4, 0, 0);
        __builtin_amdgcn_global_load_lds((const unsigned*)(src + 64 + lane), (PG8_LAS unsigned*)(dst + 256), 4, 0, 0);
    }
    __device__ __forceinline__ void operator()(const f32x4 (&acc)[2][2][4][2], const Unit& u, int wr, int wc, int fr, int fq, const PG8_LAS unsigned char* lds, int buf) const {
        constexpr int DFFc = 11008, DFF2c = 22016;
        const PG8_LAS unsigned char* cl = lds + CONV_LDS + buf * 4096;
        const int lc = wc * 32 + 8 * fq, gc = u.pn * HALF + lc, run0 = u.pm * BM + wr * 64;
        unsigned pk[2][4][2];
#pragma unroll
        for (int n = 0; n < 2; ++n) {
            const int cg = gc + 4 * n, cu = DFFc + gc + 4 * n;
            const int lo4 = (lc + 4 * n) * 4; (void)cg; (void)cu;
#define PG8_CL(s) (*(const PG8_LAS f32x4*)(cl + (s) * 512 + lo4))
            constexpr float ASC = 1.0f / (float)(1 << ASH), CG = -1.4426950408889634f, CU = (F8OUT ? 4.0f : 1.0f) / CG, TG = CG * ASC, TU = CU * ASC;
            const f32x4 wg0 = PG8_CL(0) * TG, wg1 = PG8_CL(2) * TG, wg2 = PG8_CL(4) * TG, bg = PG8_CL(6) * CG;
            const f32x4 wu0 = PG8_CL(1) * TU, wu1 = PG8_CL(3) * TU, wu2 = PG8_CL(5) * TU, bu = PG8_CL(7) * CU;
#undef PG8_CL
#pragma unroll
            for (int ai = 0; ai < 2; ++ai) {
                f32x4 pg1 = (f32x4){0.f, 0.f, 0.f, 0.f}, pg2 = pg1, pu1 = pg1, pu2 = pg1;
                const int run = (run0 + ai * HALF) >> 6;
#pragma unroll
                for (int m = 0; m < 4; ++m) {
                    const f32x4 g = acc[ai][0][m][n], uu = acc[ai][1][m][n];
                    const f32x4 r1g = dpp_ror1(g), r2g = dpp_ror2(g), r1u = dpp_ror1(uu), r2u = dpp_ror2(uu);
                    const f32x4 s1g = fr == 0 ? pg1 : r1g, s2g = fr < 2 ? pg2 : r2g, s1u = fr == 0 ? pu1 : r1u, s2u = fr < 2 ? pu2 : r2u;
                    const f32x4 yg = bg + wg0 * s2g + wg1 * s1g + wg2 * g, yu = bu + wu0 * s2u + wu1 * s1u + wu2 * uu;
                    float a[4];
#pragma unroll
                    for (int i = 0; i < 4; ++i) a[i] = yg[i] * __builtin_amdgcn_rcpf(1.0f + __builtin_amdgcn_exp2f(yg[i])) * yu[i];
                    if constexpr (F8OUT) {
                        const unsigned q8 = pack4_fp8_e(a[0], a[1], a[2], a[3]);
                        if (n == 0) pk[ai][m][0] = q8;
                        else if (m > 0 || fr >= 2) { u32x2 w; w.x = pk[ai][m][0]; w.y = q8; *(u32x2*)((unsigned char*)ACT + (size_t)(run0 + ai * HALF + m * 16 + fr) * DFFc + gc) = w; }
                    } else {
                        const unsigned lo = cvt_pk_bf16(a[0], a[1]), hi = cvt_pk_bf16(a[2], a[3]);
                        if (n == 0) { pk[ai][m][0] = lo; pk[ai][m][1] = hi; }
                        else if (m > 0 || fr >= 2) { u32x4 w; w.x = pk[ai][m][0]; w.y = pk[ai][m][1]; w.z = lo; w.w = hi; *(u32x4*)(ACT + (size_t)(run0 + ai * HALF + m * 16 + fr) * DFFc + gc) = w; }
                    }
                    if ((m == 0 && fr < 2) || (m == 3 && fr >= 14)) {
                        const int slot = m == 0 ? 2 + fr : fr - 14;
                        bf16_t* hp = UH + ((size_t)run * 4 + slot) * DFF2c + u.pn * BM + lc + 4 * n;
                        const f32x4 gs = ASH ? g * ASC : g, us = ASH ? uu * ASC : uu;
                        u32x2 hg, hu; hg.x = cvt_pk_bf16(gs[0], gs[1]); hg.y = cvt_pk_bf16(gs[2], gs[3]); hu.x = cvt_pk_bf16(us[0], us[1]); hu.y = cvt_pk_bf16(us[2], us[3]);
                        *(u32x2*)hp = hg; *(u32x2*)(hp + HALF) = hu; }
                    pg1 = r1g; pg2 = r2g; pu1 = r1u; pu2 = r2u;
                }
            }
        }
    }
};

template <class Epi, class Sched, bool ALIGN_EPI = false, bool SP2 = false, int MODE = 0, bool F8 = false>
__device__ __forceinline__ void gemm_phase(PG8_LAS unsigned char* lds, const Gemm g, const Sched& S, const Epi& E, const int tid_in) {
    const int tid = tid_in, wid = __builtin_amdgcn_readfirstlane(tid >> 6), lane = tid & 63, wr = wid >> 2, wc = wid & 3, fr = lane & 15, fq = lane >> 4;
    const int K = g.K, nt = K / BK;
    const int lda = MODE ? g.lda : K;
    unsigned voffA[2], voffB[2];
#pragma unroll
    for (int i = 0; i < 2; ++i) { int R, C; stage_rc(tid * 16 + i * 8192, R, C); const int Rb = Epi::PERM ? ((R & ~31) + perm32(R & 31)) : R;
        voffA[i] = (unsigned)(R * lda + C) * 2u; voffB[i] = (unsigned)(Rb * K + C) * 2u; }
    const size_t kstep = (size_t)(BK * 2);
    const size_t hstepB = (size_t)HALF * K * 2, tstepB = 2 * hstepB;
    const size_t hstepA = (MODE == 2) ? (size_t)(F8 ? 512 : 1024) : (size_t)HALF * lda * 2;
    const size_t tstepA = (MODE == 2) ? (size_t)HALF * lda * 2 : 2 * (size_t)HALF * lda * 2;
#define PG8_APTR(u) ((const char*)g.A + (size_t)(u).pm * tstepA + (MODE == 1 ? (size_t)((u).pn >> 1) * 256 : (MODE == 2 ? (size_t)(u).pn * (F8 ? 1024 : 2048) : (size_t)0)))
#define PG8_BPTR(u) ((const char*)g.Bt + (size_t)(u).pn * tstepB)
#define PG8_MMAX(ai, bj, At, Bt) do { if constexpr (MODE != 2) PG8_MMA(ai, bj, At, Bt); } while (0)
    const unsigned ldsw = (unsigned)wid * 1024u;
    const int aoff = lds_byte(wr * 64 + fr, fq * 8), boff = lds_byte(wc * 32 + fr, fq * 8);
#define PG8_SA(b, h) (((b) * 2 + (h)) * HTB)
#define PG8_SB(b, h) ((4 + (b) * 2 + (h)) * HTB)
#define PG8_STAGE(bufoff, gbase, voff) do { _Pragma("unroll") for (int _i = 0; _i < 2; ++_i) \
        __builtin_amdgcn_global_load_lds((const unsigned*)((const char*)(gbase) + (voff)[_i]), (PG8_LAS unsigned*)(lds + (bufoff) + ldsw + _i * 8192), 16, 0, 0); } while (0)
#define PG8_LDA(dst, b, h) do { _Pragma("unroll") for (int m = 0; m < 4; ++m) _Pragma("unroll") for (int k = 0; k < 2; ++k) dst[m][k] = *(const PG8_LAS bf16x8*)(lds + PG8_SA(b, h) + aoff + m * 2048 + k * 1024); } while (0)
#define PG8_LDB(dst, b, h) do { _Pragma("unroll") for (int n = 0; n < 2; ++n) _Pragma("unroll") for (int k = 0; k < 2; ++k) dst[n][k] = *(const PG8_LAS bf16x8*)(lds + PG8_SB(b, h) + boff + n * 2048 + k * 1024); } while (0)
#define PG8_MMA(ai, bj, At, Bt) do { __builtin_amdgcn_s_setprio(1); \
        if constexpr (F8) { _Pragma("unroll") for (int m = 0; m < 4; ++m) _Pragma("unroll") for (int n = 0; n < 2; ++n) { \
            const v8i_t b8 = __builtin_shufflevector(__builtin_bit_cast(v4i_t, Bt[n][0]), __builtin_bit_cast(v4i_t, Bt[n][1]), 0, 1, 2, 3, 4, 5, 6, 7); \
            const v8i_t a8 = __builtin_shufflevector(__builtin_bit_cast(v4i_t, At[m][0]), __builtin_bit_cast(v4i_t, At[m][1]), 0, 1, 2, 3, 4, 5, 6, 7); \
            asm("v_mfma_f32_16x16x128_f8f6f4 %0, %1, %2, %0" : "+v"(acc[ai][bj][m][n]) : "v"(b8), "v"(a8)); } } \
        else { _Pragma("unroll") for (int m = 0; m < 4; ++m) _Pragma("unroll") for (int n = 0; n < 2; ++n) _Pragma("unroll") for (int k = 0; k < 2; ++k) \
            acc[ai][bj][m][n] = __builtin_amdgcn_mfma_f32_16x16x32_bf16(Bt[n][k], At[m][k], acc[ai][bj][m][n], 0, 0, 0); } \
        __builtin_amdgcn_s_setprio(0); } while (0)
#define PG8_WAIT_V(n) asm volatile("s_waitcnt vmcnt(" #n ")" ::: "memory")
#define PG8_WAIT_L(n) asm volatile("s_waitcnt lgkmcnt(" #n ")" ::: "memory")
#define PG8_BAR __builtin_amdgcn_s_barrier()
#define PG8_SCHED __builtin_amdgcn_sched_barrier(0)
    Unit cur, nxt; int ui = 0;
    if (!S.next(0, cur)) return;
    f32x4 acc[2][2][4][2];
#pragma unroll
    for (int a = 0; a < 2; ++a)
#pragma unroll
        for (int b = 0; b < 2; ++b)
#pragma unroll
            for (int m = 0; m < 4; ++m)
#pragma unroll
                for (int n = 0; n < 2; ++n) acc[a][b][m][n] = (f32x4){0.f, 0.f, 0.f, 0.f};
    bf16x8 At[4][2], B0[2][2], B1[2][2];
    const char* cA = PG8_APTR(cur); const char* cB = PG8_BPTR(cur);
    S.a_ready(cur);
    if constexpr (Epi::LDS_PRE) E.prefetch(cur, lds, wid, lane, 0);
    if constexpr (SP2) {
        PG8_STAGE(PG8_SB(0, 0), cB, voffB); PG8_STAGE(PG8_SB(0, 1), cB + hstepB, voffB); PG8_STAGE(PG8_SA(0, 0), cA, voffA); PG8_STAGE(PG8_SA(0, 1), cA + hstepA, voffA);
        if (wr == 1) PG8_BAR;
        PG8_WAIT_V(2); PG8_BAR;
        PG8_STAGE(PG8_SB(1, 0), cB + kstep, voffB); PG8_STAGE(PG8_SA(1, 0), cA + kstep, voffA); PG8_STAGE(PG8_SB(1, 1), cB + hstepB + kstep, voffB);
        PG8_WAIT_V(6); PG8_BAR;
    } else {
        PG8_STAGE(PG8_SB(0, 0), cB, voffB); PG8_STAGE(PG8_SA(0, 0), cA, voffA); PG8_STAGE(PG8_SB(0, 1), cB + hstepB, voffB); PG8_STAGE(PG8_SA(0, 1), cA + hstepA, voffA);
        if (wr == 1) PG8_BAR;
        PG8_WAIT_V(4); PG8_BAR;
        PG8_STAGE(PG8_SB(1, 0), cB + kstep, voffB); PG8_STAGE(PG8_SA(1, 0), cA + kstep, voffA); PG8_STAGE(PG8_SB(1, 1), cB + hstepB + kstep, voffB);
        PG8_WAIT_V(6); PG8_BAR;
    }
    for (;;) {
        const bool has_next = S.next(ui + 1, nxt);
        const char* nA = has_next ? PG8_APTR(nxt) : cA; const char* nB = has_next ? PG8_BPTR(nxt) : cB;
        for (int t = 0; t < nt; t += 2) {
            const bool last = (t == nt - 2);
            const char* a1 = cA + (size_t)(t + 1) * kstep;
            const char* a2 = last ? nA : cA + (size_t)(t + 2) * kstep; const char* b2 = last ? nB : cB + (size_t)(t + 2) * kstep;
            const char* a3 = a2 + kstep; const char* b3 = b2 + kstep;
            if (last && has_next) S.a_ready(nxt);
            if constexpr (SP2) {
            PG8_LDB(B0, 0, 0); PG8_LDB(B1, 0, 1); PG8_SCHED; PG8_LDA(At, 0, 0); PG8_STAGE(PG8_SA(1, 1), a1 + hstepA, voffA);
            PG8_WAIT_V(8); PG8_WAIT_L(0); PG8_BAR; PG8_MMA(0, 0, At, B0); PG8_MMAX(0, 1, At, B1); PG8_BAR; PG8_SCHED;
            PG8_LDA(At, 0, 1); PG8_STAGE(PG8_SB(0, 0), b2, voffB); PG8_STAGE(PG8_SB(0, 1), b2 + hstepB, voffB); PG8_STAGE(PG8_SA(0, 0), a2, voffA);
            PG8_WAIT_V(8); PG8_WAIT_L(0); PG8_BAR; PG8_MMAX(1, 0, At, B0); PG8_MMA(1, 1, At, B1); PG8_BAR; PG8_SCHED;
            PG8_LDB(B0, 1, 0); PG8_LDB(B1, 1, 1); PG8_SCHED; PG8_LDA(At, 1, 0); PG8_STAGE(PG8_SA(0, 1), a2 + hstepA, voffA);
            PG8_WAIT_V(8); PG8_WAIT_L(0); PG8_BAR; PG8_MMA(0, 0, At, B0); PG8_MMAX(0, 1, At, B1); PG8_BAR; PG8_SCHED;
            PG8_LDA(At, 1, 1); PG8_STAGE(PG8_SB(1, 0), b3, voffB); PG8_STAGE(PG8_SB(1, 1), b3 + hstepB, voffB); PG8_STAGE(PG8_SA(1, 0), a3, voffA);
            PG8_WAIT_V(8); PG8_WAIT_L(0); PG8_BAR; PG8_MMAX(1, 0, At, B0); PG8_MMA(1, 1, At, B1); PG8_BAR; PG8_SCHED;
            } else {
            PG8_LDB(B0, 0, 0); PG8_SCHED; PG8_LDA(At, 0, 0); PG8_STAGE(PG8_SA(1, 1), a1 + hstepA, voffA);
            PG8_WAIT_L(8); PG8_BAR; PG8_WAIT_L(0); PG8_MMA(0, 0, At, B0); PG8_BAR; PG8_SCHED;
            PG8_LDB(B1, 0, 1); PG8_STAGE(PG8_SB(0, 0), b2, voffB);
            PG8_BAR; PG8_WAIT_L(0); PG8_MMAX(0, 1, At, B1); PG8_BAR;
            PG8_LDA(At, 0, 1); PG8_STAGE(PG8_SA(0, 0), a2, voffA);
            PG8_BAR; PG8_WAIT_L(0); PG8_MMAX(1, 0, At, B0); PG8_BAR; PG8_SCHED;
            PG8_STAGE(PG8_SB(0, 1), b2 + hstepB, voffB);
            PG8_WAIT_V(6); PG8_BAR; PG8_MMA(1, 1, At, B1); PG8_BAR;
            PG8_LDB(B0, 1, 0); PG8_SCHED; PG8_LDA(At, 1, 0); PG8_STAGE(PG8_SA(0, 1), a2 + hstepA, voffA);
            PG8_WAIT_L(8); PG8_BAR; PG8_WAIT_L(0); PG8_MMA(0, 0, At, B0); PG8_BAR; PG8_SCHED;
            PG8_LDB(B1, 1, 1); PG8_STAGE(PG8_SB(1, 0), b3, voffB);
            PG8_BAR; PG8_WAIT_L(0); PG8_MMAX(0, 1, At, B1); PG8_BAR;
            PG8_LDA(At, 1, 1); PG8_STAGE(PG8_SA(1, 0), a3, voffA);
            PG8_BAR; PG8_WAIT_L(0); PG8_MMAX(1, 0, At, B0); PG8_BAR; PG8_SCHED;
            PG8_STAGE(PG8_SB(1, 1), b3 + hstepB, voffB);
            PG8_WAIT_V(6); PG8_BAR; PG8_MMA(1, 1, At, B1); PG8_BAR;
            }
        }
        if constexpr (F8) asm volatile("s_nop 15\n\ts_nop 15" ::: "memory");
        if constexpr (ALIGN_EPI) { if (wr == 0) PG8_BAR; }
        if constexpr (Epi::LDS_PRE) { if (has_next) E.prefetch(nxt, lds, wid, lane, (ui + 1) & 1); E(acc, cur, wr, wc, fr, fq, lds, ui & 1); S.done(cur); }
        else if constexpr (!Epi::AFTER_DRAIN) { E(acc, cur, wr, wc, fr, fq); S.done(cur); }
        if (!has_next) break;
#pragma unroll
        for (int a = 0; a < 2; ++a)
#pragma unroll
            for (int b = 0; b < 2; ++b)
#pragma unroll
                for (int m = 0; m < 4; ++m)
#pragma unroll
                    for (int n = 0; n < 2; ++n) acc[a][b][m][n] = (f32x4){0.f, 0.f, 0.f, 0.f};
        cur = nxt; cA = nA; cB = nB; ++ui;
        if constexpr (ALIGN_EPI) { if (wr == 1) PG8_BAR; }
    }
    PG8_WAIT_V(0);
    if constexpr (!ALIGN_EPI) { if (wr == 0) PG8_BAR; }
    PG8_BAR;
    if constexpr (Epi::AFTER_DRAIN) { E.fused(acc, cur, wr, wc, fr, fq, lds, wid, lane); S.done(cur); }
#undef PG8_SA
#undef PG8_APTR
#undef PG8_BPTR
#undef PG8_MMAX
#undef PG8_SB
#undef PG8_STAGE
#undef PG8_LDA
#undef PG8_LDB
#undef PG8_MMA
#undef PG8_WAIT_V
#undef PG8_WAIT_L
#undef PG8_BAR
#undef PG8_SCHED
}
}

constexpr int NWAVES = 8, NTHR = NWAVES * 64;
constexpr int D = 4096, SEQ = 8192, M = 2 * SEQ;
constexpr int GLA_IN_N = 12304, GLA_IN_NP = 12544;
constexpr int DSA_IN_N = 1728, DSA_IN_NP = 1792;
constexpr int DFF = 11008, DFF2 = 22016;
constexpr float RMS_EPS = 1e-6f;
constexpr float ACT_SC = 4.0f, WDN_SC = 128.0f; constexpr int DN_SH = 9;
constexpr float HN8_SC = 16.0f, WUP_SC = 128.0f; constexpr int UP_SH = 11;
constexpr float DSO_SC = 32.0f, WO_SC = 128.0f; constexpr int DSAO_SH = 12;
constexpr float OL_SC = 64.0f, WUV_SC = 128.0f;
constexpr float QL_SC = 16.0f;
constexpr float CQ_SC = 16.0f, WQ_SC = 128.0f; constexpr int QUP_SH = 11;

constexpr size_t MiB = 1u << 20;
constexpr size_t WS_CTL = 0, CTL_ZERO_BYTES = 64 * 1024;
constexpr size_t WS_W_GLA_IN = 1 * MiB;
constexpr size_t WS_W_GLA_O  = WS_W_GLA_IN + 98 * MiB;
constexpr size_t WS_W_DSA_IN = WS_W_GLA_O + 32 * MiB;
constexpr size_t WS_W_QUP    = WS_W_DSA_IN + 14 * MiB;
constexpr size_t WS_W_UK     = WS_W_QUP + 32 * MiB;
constexpr size_t WS_W_UV     = WS_W_UK + 8 * MiB;
constexpr size_t WS_W_DSA_O  = WS_W_UV + 8 * MiB;
constexpr size_t WS_W_UP     = WS_W_DSA_O + 64 * MiB;
constexpr size_t WS_W_DN     = WS_W_UP + 344 * MiB;
constexpr size_t WS_H        = WS_W_DN + 172 * MiB;
constexpr size_t WS_CQN8     = WS_H + 128 * MiB;
constexpr size_t WS_HN       = WS_H + 256 * MiB;
constexpr size_t WS_BIG      = WS_HN + 128 * MiB;
constexpr size_t WS_GQ   = WS_BIG;
constexpr size_t WS_GK   = WS_GQ + 64 * MiB;
constexpr size_t WS_GV   = WS_GK + 64 * MiB;
constexpr size_t WS_GR   = WS_GV + 128 * MiB;
constexpr size_t WS_GA1  = WS_GR + 128 * MiB;
constexpr size_t WS_GKT  = WS_GA1 + 1 * MiB;
constexpr size_t WS_GEBL = WS_GKT + 64 * MiB;
constexpr size_t WS_GORAW = WS_GEBL + 2 * MiB;
constexpr size_t WS_GOG  = WS_GORAW + 256 * MiB;
constexpr size_t WS_GLA_END = WS_GOG + 128 * MiB;
constexpr size_t WS_U    = WS_BIG;
constexpr size_t WS_ACT  = WS_U + 688 * MiB;
constexpr size_t WS_FFN_END = WS_ACT + 344 * MiB;
constexpr size_t WS_CKV  = WS_BIG;
constexpr size_t WS_KIDX = WS_CKV + 16 * MiB;
constexpr size_t WS_WIDX = WS_KIDX + 4 * MiB;
constexpr size_t WS_SEL  = WS_WIDX + 4 * MiB;
constexpr size_t WS_CQN  = WS_SEL + 16 * MiB;
constexpr size_t WS_QATT = WS_CQN + 32 * MiB;
constexpr size_t WS_X    = WS_QATT + 256 * MiB;
constexpr size_t WS_Z    = WS_X;
constexpr size_t WS_QIDX = WS_X + 128 * MiB;
constexpr size_t WS_SC   = WS_X + 384 * MiB;
constexpr size_t WS_QLAT = WS_X;
constexpr size_t WS_DSA_END = WS_X + 1024 * MiB;
constexpr size_t WS_END = WS_DSA_END > WS_FFN_END ? (WS_DSA_END > WS_GLA_END ? WS_DSA_END : WS_GLA_END) : (WS_FFN_END > WS_GLA_END ? WS_FFN_END : WS_GLA_END);
static_assert(WS_SC + 512 * MiB <= WS_DSA_END && WS_QIDX + 256 * MiB <= WS_SC && WS_Z + 112 * MiB <= WS_QIDX, "DSA map");
static_assert(WS_END <= (size_t)2752 * MiB, "workspace over the guaranteed size");

constexpr int CW_BAR = 4096;
constexpr int LDS_BYTES = 159744;
constexpr int MISC_OFF = 158720;

#define LDS_WAIT() asm volatile("s_waitcnt lgkmcnt(0)" ::: "memory")
#define VM_WAIT() asm volatile("s_waitcnt vmcnt(0)" ::: "memory")
__device__ __forceinline__ unsigned f2bf(float f) { unsigned u = __builtin_bit_cast(unsigned, f); return (u + 0x7fffu + ((u >> 16) & 1u)) >> 16; }
__device__ __forceinline__ unsigned pk2(float lo, float hi) { return f2bf(lo) | (f2bf(hi) << 16); }
__device__ __forceinline__ float bf2f(unsigned b) { return __builtin_bit_cast(float, b << 16); }
__device__ __forceinline__ float bflo(unsigned w) { return __builtin_bit_cast(float, w << 16); }
__device__ __forceinline__ float bfhi(unsigned w) { return __builtin_bit_cast(float, w & 0xffff0000u); }
__device__ __forceinline__ float wave_sum(float v) {
#pragma unroll
    for (int o = 1; o < 64; o <<= 1) v += __shfl_xor(v, o);
    return v;
}
__device__ __forceinline__ float wave_max(float v) {
#pragma unroll
    for (int o = 1; o < 64; o <<= 1) v = fmaxf(v, __shfl_xor(v, o));
    return v;
}
__device__ __forceinline__ float u2f(unsigned u) { return __builtin_bit_cast(float, u); }
__device__ __forceinline__ unsigned f2u(float f) { return __builtin_bit_cast(unsigned, f); }
__device__ __forceinline__ float xmax_rows(float x) {
    auto r = __builtin_amdgcn_permlane16_swap(f2u(x), f2u(x), false, false); const unsigned r0 = r[0], r1 = r[1]; const float m = fmaxf(u2f(r0), u2f(r1));
    auto q = __builtin_amdgcn_permlane32_swap(f2u(m), f2u(m), false, false); const unsigned q0 = q[0], q1 = q[1]; return fmaxf(u2f(q0), u2f(q1)); }
__device__ __forceinline__ float xsum_rows(float x) {
    auto r = __builtin_amdgcn_permlane16_swap(f2u(x), f2u(x), false, false); const unsigned r0 = r[0], r1 = r[1]; const float m = u2f(r0) + u2f(r1);
    auto q = __builtin_amdgcn_permlane32_swap(f2u(m), f2u(m), false, false); const unsigned q0 = q[0], q1 = q[1]; return u2f(q0) + u2f(q1); }
__device__ __forceinline__ float swapsum32(float a, float b) {
    auto r = __builtin_amdgcn_permlane32_swap(f2u(a), f2u(b), false, false); const unsigned r0 = r[0], r1 = r[1]; return u2f(r0) + u2f(r1); }
__device__ __forceinline__ float swapsum16(float a, float b) {
    auto r = __builtin_amdgcn_permlane16_swap(f2u(a), f2u(b), false, false); const unsigned r0 = r[0], r1 = r[1]; return u2f(r0) + u2f(r1); }
__device__ __forceinline__ int hw_lane() { unsigned ones = ~0u; asm volatile("" : "+s"(ones)); return (int)__builtin_amdgcn_mbcnt_hi(ones, __builtin_amdgcn_mbcnt_lo(ones, 0u)); }
__device__ __forceinline__ f32x4 mfma16(bf16x8 a, bf16x8 b, f32x4 c) { return __builtin_amdgcn_mfma_f32_16x16x32_bf16(a, b, c, 0, 0, 0); }
__device__ __forceinline__ bf16x8 lfrag(const LAS unsigned char* base, int row, int pitch, int col) { return *(const LAS bf16x8*)(base + row * pitch + col * 2); }

#define XB_TMO      128
#define XB_XCNT(j)  (256  + 64 * (j))
#define XB_XSUB(j)  (1280 + 64 * (j))
#define XB_XGEN(j)  (2304 + 64 * (j))
#define XB_TOP      3328
#define XB_TOPGEN   3392
#define XCD_BAR_WORDS 3456
#define XB_SPIN_CAP (1u << 18)

__device__ __forceinline__ unsigned xb_ld(unsigned* p)              { return __hip_atomic_load(p, __ATOMIC_RELAXED, __HIP_MEMORY_SCOPE_AGENT); }
__device__ __forceinline__ unsigned xb_add(unsigned* p, unsigned v) { return __hip_atomic_fetch_add(p, v, __ATOMIC_RELAXED, __HIP_MEMORY_SCOPE_AGENT); }
__device__ __forceinline__ unsigned xb_xcc_id() { return (unsigned)__builtin_amdgcn_s_getreg((3 << 11) | 20) & 0xFu; }
#define XB_SPIN(cond, bar) do { unsigned _sp = 0; while (cond) { __builtin_amdgcn_s_sleep(1); \
    if ((++_sp & 255u) == 0u) { if (xb_ld(&(bar)[XB_TMO])) break; if (_sp > XB_SPIN_CAP) { atomicAdd(&(bar)[XB_TMO], 1u); break; } } } } while (0)

struct XcdBarrier {
    unsigned* bar; unsigned x;
    volatile LAS unsigned* st;
};

__device__ __forceinline__ XcdBarrier xcd_barrier_post(unsigned* bar, volatile LAS unsigned* st) {
    XcdBarrier b; b.bar = bar; b.x = xb_xcc_id(); b.st = st;
    if (threadIdx.x == 0) (void)xb_add(&bar[XB_XCNT(b.x)], 1u);
    return b;
}
__device__ __forceinline__ void xcd_barrier_complete(unsigned* bar, unsigned x, unsigned& nloc, unsigned& nx) {
    const unsigned G = gridDim.x * gridDim.y * gridDim.z;
    unsigned sum, cnt, mine, sp = 0u;
    for (;;) {
        sum = 0u; cnt = 0u; mine = 0u;
#pragma unroll
        for (unsigned j = 0; j < 16; ++j) { const unsigned c = xb_ld(&bar[XB_XCNT(j)]); sum += c; cnt += (c > 0u) ? 1u : 0u; mine = (j == x) ? c : mine; }
        if (sum == G) break;
        __builtin_amdgcn_s_sleep(1);
        if ((++sp & 255u) == 0u) { if (xb_ld(&bar[XB_TMO])) break; if (sp > XB_SPIN_CAP) { atomicAdd(&bar[XB_TMO], 1u); break; } }
    }
    nloc = mine > 0u ? mine : 1u; nx = cnt > 0u ? cnt : 1u;
}

__device__ __forceinline__ void xcd_barrier(const XcdBarrier& b, const bool t0  ) {
    asm volatile("s_waitcnt vmcnt(0)" ::: "memory");
    __syncthreads();
    if (t0) {
        unsigned* bar = b.bar;
        __builtin_amdgcn_s_waitcnt(0);
        unsigned nloc = b.st[0], nx = b.st[1];
        if (nloc == 0u) { xcd_barrier_complete(bar, b.x, nloc, nx); b.st[0] = nloc; b.st[1] = nx; }
        const unsigned old = xb_add(&bar[XB_XSUB(b.x)], 1u);
        const unsigned gen = old / nloc;
        if (old + 1u == (gen + 1u) * nloc) {
            __builtin_amdgcn_fence(__ATOMIC_RELEASE, "agent");
            asm volatile("s_waitcnt vmcnt(0)" ::: "memory");
            const unsigned og = xb_add(&bar[XB_TOP], 1u);
            const unsigned tg = og / nx;
            if (og + 1u == (tg + 1u) * nx) xb_add(&bar[XB_TOPGEN], 1u);
            else XB_SPIN(xb_ld(&bar[XB_TOPGEN]) == tg, bar);
            __builtin_amdgcn_fence(__ATOMIC_ACQUIRE, "agent");
            xb_add(&bar[XB_XGEN(b.x)], 1u);
            asm volatile("s_waitcnt vmcnt(0)" ::: "memory");
        } else {
            XB_SPIN(xb_ld(&bar[XB_XGEN(b.x)]) == gen, bar);
            __builtin_amdgcn_fence(__ATOMIC_ACQUIRE, "agent");
            asm volatile("s_waitcnt vmcnt(0)" ::: "memory");
        }
    }
    __syncthreads();
}

__device__ __forceinline__ unsigned pack4_fp8(float a, float b, float c2, float d) {
    a = __builtin_amdgcn_fmed3f(a, -448.f, 448.f); b = __builtin_amdgcn_fmed3f(b, -448.f, 448.f); c2 = __builtin_amdgcn_fmed3f(c2, -448.f, 448.f); d = __builtin_amdgcn_fmed3f(d, -448.f, 448.f);
    int p = 0; p = __builtin_amdgcn_cvt_pk_fp8_f32(a, b, p, false); p = __builtin_amdgcn_cvt_pk_fp8_f32(c2, d, p, true); return (unsigned)p; }
template <bool ILV> struct TrItem { const float* W; bf16_t* WT; int k0, n0, d0; };
template <bool ILV, bool O8 = false> __device__ __forceinline__ TrItem<ILV> tr_decode(const float* W, int batch_per, int K, int N, int Npad, bf16_t* WT, int it) {
    const int bi = it / batch_per, item = it - bi * batch_per;
    const int nblk = Npad / 64, kb = item / nblk, nb = item - kb * nblk, n0 = 64 * nb;
    const int d0 = ILV ? (n0 < DFF ? 256 * (n0 >> 7) + (n0 & 127) : 256 * ((n0 - DFF) >> 7) + 128 + ((n0 - DFF) & 127)) : n0;
    return TrItem<ILV>{W + (size_t)bi * K * N, WT + (size_t)bi * Npad * K / (O8 ? 2 : 1), 64 * kb, n0, d0};
}
template <bool ILV> __device__ __forceinline__ void tr_load(f32x4 (&v)[16], const TrItem<ILV>& t, int N, int lane) {
    const int r4 = lane >> 4, c4 = lane & 15, nn = t.n0 + 4 * c4; const bool ok = nn < N;
#pragma unroll
    for (int i = 0; i < 16; ++i) v[i] = ok ? __builtin_nontemporal_load((const f32x4*)(t.W + (size_t)(t.k0 + 4 * i + r4) * N + nn)) : (f32x4){0.f, 0.f, 0.f, 0.f};
}
template <bool ILV, bool O8> __device__ __forceinline__ void tr_store(const f32x4 (&v)[16], const TrItem<ILV>& t, int K, LAS float* scr, int lane, float osc) {
    const int r4 = lane >> 4, c4 = lane & 15;
#pragma unroll
    for (int i = 0; i < 16; ++i) { LAS float* s = scr + (4 * i + r4) * 65 + 4 * c4; s[0] = v[i].x; s[1] = v[i].y; s[2] = v[i].z; s[3] = v[i].w; }
    LDS_WAIT(); asm volatile("" ::: "memory");
    const int c = lane & 7;
#pragma unroll
    for (int j = 0; j < 8; ++j) { const int n = (lane >> 3) + 8 * j; const LAS float* s = scr + (8 * c) * 65 + n;
        if (O8) { u32x2 o; o.x = pack4_fp8(s[0 * 65] * osc, s[1 * 65] * osc, s[2 * 65] * osc, s[3 * 65] * osc); o.y = pack4_fp8(s[4 * 65] * osc, s[5 * 65] * osc, s[6 * 65] * osc, s[7 * 65] * osc);
            *(u32x2*)((unsigned char*)t.WT + (size_t)(t.d0 + n) * K + t.k0 + 8 * c) = o; }
        else { u32x4 o; o.x = pk2(s[0 * 65], s[1 * 65]); o.y = pk2(s[2 * 65], s[3 * 65]); o.z = pk2(s[4 * 65], s[5 * 65]); o.w = pk2(s[6 * 65], s[7 * 65]);
            *(u32x4*)(t.WT + (size_t)(t.d0 + n) * K + t.k0 + 8 * c) = o; } }
    LDS_WAIT(); asm volatile("" ::: "memory");
}
template <bool ILV = false, bool O8 = false> __device__ __forceinline__ void convert_matrix(const float* W, int batch, int K, int N, int Npad, bf16_t* WT, LAS float* scr, int gw, int NGW, int lane, float osc = 1.0f) {
    const int per = (K / 64) * (Npad / 64), total = batch * per;
    int it = gw; if (it >= total) return;
    f32x4 va[16], vb[16];
    TrItem<ILV> ta = tr_decode<ILV, O8>(W, per, K, N, Npad, WT, it), tb = ta;
    tr_load<ILV>(va, ta, N, lane);
    for (;;) {
        int nx = it + NGW; const bool hb = nx < total;
        if (hb) { tb = tr_decode<ILV, O8>(W, per, K, N, Npad, WT, nx); tr_load<ILV>(vb, tb, N, lane); }
        tr_store<ILV, O8>(va, ta, K, scr, lane, osc);
        if (!hb) break;
        it = nx; nx = it + NGW; const bool ha = nx < total;
        if (ha) { ta = tr_decode<ILV, O8>(W, per, K, N, Npad, WT, nx); tr_load<ILV>(va, ta, N, lane); }
        tr_store<ILV, O8>(vb, tb, K, scr, lane, osc);
        if (!ha) break;
        it = nx;
    }
}
__device__ __forceinline__ void rmsnorm_rows_bf16(const float* X, const float* g, bf16_t* O, int gw, int NGW, int lane) {
    f32x4 gg[16];
#pragma unroll
    for (int j = 0; j < 16; ++j) gg[j] = ((const f32x4*)g)[lane + 64 * j];
    f32x4 nx[16];
    if (gw < M) { const f32x4* xr = (const f32x4*)(X + (size_t)gw * D) + lane;
#pragma unroll
        for (int j = 0; j < 16; ++j) nx[j] = xr[64 * j]; }
    for (int m = gw; m < M; m += NGW) {
        f32x4 v[16]; float s = 0.f;
#pragma unroll
        for (int j = 0; j < 16; ++j) { v[j] = nx[j]; s += (v[j].x * v[j].x + v[j].y * v[j].y) + (v[j].z * v[j].z + v[j].w * v[j].w); }
        if (m + NGW < M) { const f32x4* xn = (const f32x4*)(X + (size_t)(m + NGW) * D) + lane;
#pragma unroll
            for (int j = 0; j < 16; ++j) nx[j] = xn[64 * j]; }
        const float rstd = 1.0f / sqrtf(wave_sum(s) * (1.0f / D) + RMS_EPS);
        u32x2* o8 = (u32x2*)(O + (size_t)m * D) + lane;
#pragma unroll
        for (int j = 0; j < 16; ++j) { u32x2 w; w.x = pk2(v[j].x * rstd * gg[j].x, v[j].y * rstd * gg[j].y); w.y = pk2(v[j].z * rstd * gg[j].z, v[j].w * rstd * gg[j].w); o8[64 * j] = w; }
    }
}
template <int OUTM  > __device__ __forceinline__ void rmsnorm_rows_from_bf16(const bf16_t* X, const float* g, void* O, int gw, int NGW, int lane) {
    f32x4 gg[8][2];
#pragma unroll
    for (int j = 0; j < 8; ++j) { const int c0 = 8 * (lane + 64 * j); gg[j][0] = *(const f32x4*)(g + c0); gg[j][1] = *(const f32x4*)(g + c0 + 4); }
    u32x4 w[8];
    if (gw < M) { const u32x4* xr = (const u32x4*)(X + (size_t)gw * D) + lane;
#pragma unroll
        for (int j = 0; j < 8; ++j) w[j] = xr[64 * j]; }
    for (int m = gw; m < M; m += NGW) {
        float v[8][8]; float s = 0.f;
#pragma unroll
        for (int j = 0; j < 8; ++j) { v[j][0] = bflo(w[j].x); v[j][1] = bfhi(w[j].x); v[j][2] = bflo(w[j].y); v[j][3] = bfhi(w[j].y); v[j][4] = bflo(w[j].z); v[j][5] = bfhi(w[j].z); v[j][6] = bflo(w[j].w); v[j][7] = bfhi(w[j].w);
#pragma unroll
            for (int e = 0; e < 8; ++e) s += v[j][e] * v[j][e]; }
        if (m + NGW < M) { const u32x4* xn = (const u32x4*)(X + (size_t)(m + NGW) * D) + lane;
#pragma unroll
            for (int j = 0; j < 8; ++j) w[j] = xn[64 * j]; }
        const float rstd = 1.0f / sqrtf(wave_sum(s) * (1.0f / D) + RMS_EPS);
#pragma unroll
        for (int j = 0; j < 8; ++j) { const int c0 = 8 * (lane + 64 * j); const f32x4 g0 = gg[j][0], g1 = gg[j][1];
            const float o0 = v[j][0] * rstd * g0.x, o1 = v[j][1] * rstd * g0.y, o2 = v[j][2] * rstd * g0.z, o3 = v[j][3] * rstd * g0.w, o4 = v[j][4] * rstd * g1.x, o5 = v[j][5] * rstd * g1.y, o6 = v[j][6] * rstd * g1.z, o7 = v[j][7] * rstd * g1.w;
            if (OUTM == 1) { float* op = (float*)O + (size_t)m * D + c0; *(f32x4*)op = (f32x4){o0, o1, o2, o3}; *(f32x4*)(op + 4) = (f32x4){o4, o5, o6, o7}; }
            else if (OUTM == 2) { u32x2 ow; ow.x = pack4_fp8(o0 * HN8_SC, o1 * HN8_SC, o2 * HN8_SC, o3 * HN8_SC); ow.y = pack4_fp8(o4 * HN8_SC, o5 * HN8_SC, o6 * HN8_SC, o7 * HN8_SC); *(u32x2*)((unsigned char*)O + (size_t)m * D + c0) = ow; }
            else { u32x4 ow; ow.x = pk2(o0, o1); ow.y = pk2(o2, o3); ow.z = pk2(o4, o5); ow.w = pk2(o6, o7); *(u32x4*)((bf16_t*)O + (size_t)m * D + c0) = ow; } }
    }
}
__device__ __forceinline__ void rmsnorm_rows_f32(const float* X, const float* g, float* O, int gw, int NGW, int lane) {
    for (int m = gw; m < M; m += NGW) {
        const f32x4* xr = (const f32x4*)(X + (size_t)m * D) + lane;
        f32x4 v[16]; float s = 0.f;
#pragma unroll
        for (int j = 0; j < 16; ++j) { v[j] = xr[64 * j]; s += (v[j].x * v[j].x + v[j].y * v[j].y) + (v[j].z * v[j].z + v[j].w * v[j].w); }
        const float rstd = 1.0f / sqrtf(wave_sum(s) * (1.0f / D) + RMS_EPS);
        f32x4* o = (f32x4*)(O + (size_t)m * D) + lane;
#pragma unroll
        for (int j = 0; j < 16; ++j) { const f32x4 gg = ((const f32x4*)g)[lane + 64 * j]; o[64 * j] = v[j] * rstd * gg; }
    }
}

__device__ __forceinline__ void gla_pre_unit(int cidx, int h, bf16_t* Q, bf16_t* Kb, const float* A1, const float* w_a2, const float* b_a, bf16_t* KT, float* EBL, LAS float* tot, int tid) {
    const int dg = tid & 31, tq = tid >> 5; const int d0 = h * 256 + 8 * dg; const int m0 = cidx * 64 + 4 * tq;
    float acc[4][8];
    { const f32x4 b0 = *(const f32x4*)(b_a + d0), b1 = *(const f32x4*)(b_a + d0 + 4);
#pragma unroll
      for (int i = 0; i < 4; ++i) { acc[i][0] = b0.x; acc[i][1] = b0.y; acc[i][2] = b0.z; acc[i][3] = b0.w; acc[i][4] = b1.x; acc[i][5] = b1.y; acc[i][6] = b1.z; acc[i][7] = b1.w; } }
#pragma unroll
    for (int jq = 0; jq < 4; ++jq) {
        f32x4 a[4];
#pragma unroll
        for (int i = 0; i < 4; ++i) a[i] = *(const f32x4*)(A1 + (size_t)(m0 + i) * 16 + 4 * jq);
#pragma unroll
        for (int jj = 0; jj < 4; ++jj) { const int j = 4 * jq + jj;
            const f32x4 w0 = *(const f32x4*)(w_a2 + (size_t)j * 2048 + d0), w1 = *(const f32x4*)(w_a2 + (size_t)j * 2048 + d0 + 4);
#pragma unroll
            for (int i = 0; i < 4; ++i) { const float av = a[i][jj];
                acc[i][0] += av * w0.x; acc[i][1] += av * w0.y; acc[i][2] += av * w0.z; acc[i][3] += av * w0.w; acc[i][4] += av * w1.x; acc[i][5] += av * w1.y; acc[i][6] += av * w1.z; acc[i][7] += av * w1.w; } }
    }
#pragma unroll
    for (int i = 0; i < 4; ++i)
#pragma unroll
        for (int e = 0; e < 8; ++e) { const float x = acc[i][e]; acc[i][e] = (fminf(x, 0.f) - log1pf(__expf(-fabsf(x)))) * (1.0f / 16.0f); }
#pragma unroll
    for (int i = 1; i < 4; ++i)
#pragma unroll
        for (int e = 0; e < 8; ++e) acc[i][e] += acc[i - 1][e];
    *(LAS f32x4*)(tot + tq * 256 + 8 * dg) = (f32x4){acc[3][0], acc[3][1], acc[3][2], acc[3][3]};
    *(LAS f32x4*)(tot + tq * 256 + 8 * dg + 4) = (f32x4){acc[3][4], acc[3][5], acc[3][6], acc[3][7]};
    __syncthreads();
    float pre[8], all[8];
#pragma unroll
    for (int e = 0; e < 8; ++e) { pre[e] = 0.f; all[e] = 0.f; }
#pragma unroll
    for (int q = 0; q < 16; ++q) { const f32x4 t0 = *(const LAS f32x4*)(tot + q * 256 + 8 * dg), t1 = *(const LAS f32x4*)(tot + q * 256 + 8 * dg + 4);
        const float tv[8] = {t0.x, t0.y, t0.z, t0.w, t1.x, t1.y, t1.z, t1.w};
#pragma unroll
        for (int e = 0; e < 8; ++e) { all[e] += tv[e]; if (q < tq) pre[e] += tv[e]; } }
    float kv[4][8];
#pragma unroll
    for (int i = 0; i < 4; ++i) { const size_t off = (size_t)(m0 + i) * 2048 + d0;
        const u32x4 qw = *(const u32x4*)(Q + off), kw = *(const u32x4*)(Kb + off);
        const unsigned qa[4] = {qw.x, qw.y, qw.z, qw.w}, ka[4] = {kw.x, kw.y, kw.z, kw.w};
        float qo[8];
#pragma unroll
        for (int e2 = 0; e2 < 4; ++e2) { const float b0 = pre[2 * e2] + acc[i][2 * e2], b1 = pre[2 * e2 + 1] + acc[i][2 * e2 + 1];
            qo[2 * e2] = bflo(qa[e2]) * __expf(b0) * 0.0625f; qo[2 * e2 + 1] = bfhi(qa[e2]) * __expf(b1) * 0.0625f;
            kv[i][2 * e2] = bflo(ka[e2]) * __expf(-b0); kv[i][2 * e2 + 1] = bfhi(ka[e2]) * __expf(-b1); }
        u32x4 qs, ks; qs.x = pk2(qo[0], qo[1]); qs.y = pk2(qo[2], qo[3]); qs.z = pk2(qo[4], qo[5]); qs.w = pk2(qo[6], qo[7]);
        ks.x = pk2(kv[i][0], kv[i][1]); ks.y = pk2(kv[i][2], kv[i][3]); ks.z = pk2(kv[i][4], kv[i][5]); ks.w = pk2(kv[i][6], kv[i][7]);
        *(u32x4*)(Q + off) = qs; *(u32x4*)(Kb + off) = ks; }
#pragma unroll
    for (int e = 0; e < 8; ++e) { u32x2 w; w.x = pk2(kv[0][e], kv[1][e]); w.y = pk2(kv[2][e], kv[3][e]); *(u32x2*)(KT + ((size_t)cidx * 2048 + d0 + e) * 64 + 4 * tq) = w; }
    if (tq == 0) { *(f32x4*)(EBL + (size_t)cidx * 2048 + d0) = (f32x4){__expf(all[0]), __expf(all[1]), __expf(all[2]), __expf(all[3])};
                   *(f32x4*)(EBL + (size_t)cidx * 2048 + d0 + 4) = (f32x4){__expf(all[4]), __expf(all[5]), __expf(all[6]), __expf(all[7])}; }
    __syncthreads();
}

constexpr int SC_LQ = 0, SC_LK = 33792, SC_LKT = 67584, SC_LVT = 104448, SC_LP = 113664, SC_LST = 122880, SC_LEBL = 156672;
static_assert(SC_LEBL + 1024 <= MISC_OFF, "scan LDS map");
struct ScanRegs { u32x4 q[4], k[4], kt[4], v; float ebl; };
__device__ __forceinline__ void gla_scan_load(ScanRegs& R, int cidx, int h, int vs, const bf16_t* Q, const bf16_t* Kb, const bf16_t* KT, const bf16_t* V, const float* EBL, int tid) {
#pragma unroll
    for (int i = 0; i < 4; ++i) { const int idx = tid + 512 * i, row = idx >> 5, ch = idx & 31; const size_t off = (size_t)(cidx * 64 + row) * 2048 + h * 256 + ch * 8;
        R.q[i] = *(const u32x4*)(Q + off); R.k[i] = *(const u32x4*)(Kb + off); }
#pragma unroll
    for (int i = 0; i < 4; ++i) { const int idx = tid + 512 * i, row = idx >> 3, ch = idx & 7;
        R.kt[i] = *(const u32x4*)(KT + ((size_t)cidx * 2048 + h * 256 + row) * 64 + ch * 8); }
    { const int s = tid >> 3, ch = tid & 7; R.v = *(const u32x4*)(V + (size_t)(cidx * 64 + s) * 4096 + h * 512 + vs * 64 + ch * 8); }
    R.ebl = EBL[(size_t)cidx * 2048 + h * 256 + (tid & 255)];
}
__device__ __forceinline__ void gla_scan_store(const ScanRegs& R, LAS unsigned char* lds, int tid) {
#pragma unroll
    for (int i = 0; i < 4; ++i) { const int idx = tid + 512 * i, row = idx >> 5, ch = idx & 31;
        *(LAS u32x4*)(lds + SC_LQ + row * 528 + ch * 16) = R.q[i]; *(LAS u32x4*)(lds + SC_LK + row * 528 + ch * 16) = R.k[i]; }
#pragma unroll
    for (int i = 0; i < 4; ++i) { const int idx = tid + 512 * i, row = idx >> 3, ch = idx & 7;
        *(LAS u32x4*)(lds + SC_LKT + row * 144 + ch * 16) = R.kt[i]; }
    { const int s = tid >> 3, ch = tid & 7; const unsigned va[4] = {R.v.x, R.v.y, R.v.z, R.v.w};
#pragma unroll
      for (int e2 = 0; e2 < 4; ++e2) { *(LAS bf16_t*)(lds + SC_LVT + (ch * 8 + 2 * e2) * 144 + s * 2) = (bf16_t)(va[e2] & 0xffffu); *(LAS bf16_t*)(lds + SC_LVT + (ch * 8 + 2 * e2 + 1) * 144 + s * 2) = (bf16_t)(va[e2] >> 16); } }
    if (tid < 256) ((LAS float*)(lds + SC_LEBL))[tid] = R.ebl;
}
__device__ __forceinline__ void gla_scan_unit(int b, int h, int vs, const bf16_t* Q, const bf16_t* Kb, const bf16_t* KT, const bf16_t* V, const float* EBL, bf16_t* ORAW, LAS unsigned char* lds, int tid) {
    const int lane = tid & 63, w = __builtin_amdgcn_readfirstlane(tid >> 6), fr = lane & 15, fq = lane >> 4;
    f32x4 S[2][4];
#pragma unroll
    for (int a = 0; a < 2; ++a)
#pragma unroll
        for (int n = 0; n < 4; ++n) S[a][n] = (f32x4){0.f, 0.f, 0.f, 0.f};
    for (int i = tid; i < 33792 / 16; i += NTHR) ((LAS u32x4*)(lds + SC_LST))[i] = (u32x4){0u, 0u, 0u, 0u};
    ScanRegs R;
    gla_scan_load(R, b * 128, h, vs, Q, Kb, KT, V, EBL, tid);
    gla_scan_store(R, lds, tid);
    const int mt = w >> 1, nt0 = 2 * (w & 1);
    for (int c = 0; c < 128; ++c) {
        const int cidx = b * 128 + c;
        if (c + 1 < 128) gla_scan_load(R, cidx + 1, h, vs, Q, Kb, KT, V, EBL, tid);
        __syncthreads();
#pragma unroll
        for (int q = 0; q < 2; ++q) { const int nt = nt0 + q; f32x4 acc = (f32x4){0.f, 0.f, 0.f, 0.f};
            if (nt <= mt) {
#pragma unroll
                for (int ks = 0; ks < 8; ++ks) acc = mfma16(lfrag(lds + SC_LQ, 16 * mt + fr, 528, 32 * ks + 8 * fq), lfrag(lds + SC_LK, 16 * nt + fr, 528, 32 * ks + 8 * fq), acc); }
#pragma unroll
            for (int r = 0; r < 4; ++r) { const int t = 16 * mt + 4 * fq + r, s = 16 * nt + fr; *(LAS bf16_t*)(lds + SC_LP + t * 144 + s * 2) = (bf16_t)f2bf(s <= t ? acc[r] : 0.f); } }
        __syncthreads();
#pragma unroll
        for (int q = 0; q < 2; ++q) { const int nt = nt0 + q; f32x4 acc = (f32x4){0.f, 0.f, 0.f, 0.f};
#pragma unroll
            for (int ks = 0; ks < 2; ++ks) acc = mfma16(lfrag(lds + SC_LVT, 16 * nt + fr, 144, 32 * ks + 8 * fq), lfrag(lds + SC_LP, 16 * mt + fr, 144, 32 * ks + 8 * fq), acc);
#pragma unroll
            for (int ks = 0; ks < 8; ++ks) acc = mfma16(lfrag(lds + SC_LST, 16 * nt + fr, 528, 32 * ks + 8 * fq), lfrag(lds + SC_LQ, 16 * mt + fr, 528, 32 * ks + 8 * fq), acc);
            u32x2 ow; ow.x = pk2(acc[0], acc[1]); ow.y = pk2(acc[2], acc[3]); *(u32x2*)(ORAW + (size_t)(cidx * 64 + 16 * mt + fr) * 4096 + h * 512 + vs * 64 + 16 * nt + 4 * fq) = ow; }
#pragma unroll
        for (int mi = 0; mi < 2; ++mi) { const int dt = 2 * w + mi;
#pragma unroll
            for (int ks = 0; ks < 2; ++ks) { const bf16x8 a = lfrag(lds + SC_LKT, 16 * dt + fr, 144, 32 * ks + 8 * fq);
#pragma unroll
                for (int nt = 0; nt < 4; ++nt) S[mi][nt] = mfma16(a, lfrag(lds + SC_LVT, 16 * nt + fr, 144, 32 * ks + 8 * fq), S[mi][nt]); }
            const f32x4 eb = *(const LAS f32x4*)(lds + SC_LEBL + (16 * dt + 4 * fq) * 4);
#pragma unroll
            for (int nt = 0; nt < 4; ++nt) S[mi][nt] = S[mi][nt] * eb; }
        __syncthreads();
#pragma unroll
        for (int mi = 0; mi < 2; ++mi) { const int dt = 2 * w + mi;
#pragma unroll
            for (int nt = 0; nt < 4; ++nt) { u32x2 wv; wv.x = pk2(S[mi][nt][0], S[mi][nt][1]); wv.y = pk2(S[mi][nt][2], S[mi][nt][3]);
                *(LAS u32x2*)(lds + SC_LST + (16 * nt + fr) * 528 + (16 * dt + 4 * fq) * 2) = wv; } }
        if (c + 1 < 128) gla_scan_store(R, lds, tid);
    }
    __syncthreads();
}

__device__ __forceinline__ void gla_out_norm(const bf16_t* ORAW, const bf16_t* Rg, const float* g_out, bf16_t* OG, int gw, int NGW, int lane) {
    const f32x4 g0 = *(const f32x4*)(g_out + 4 * lane), g1 = *(const f32x4*)(g_out + 256 + 4 * lane);
    for (int m = gw; m < M; m += NGW) {
        const size_t rb = (size_t)m * 4096;
        u32x2 q0[8], q1[8], r0[8], r1[8];
#pragma unroll
        for (int h = 0; h < 8; ++h) { const size_t base = rb + h * 512;
            q0[h] = *(const u32x2*)(ORAW + base + 4 * lane); q1[h] = *(const u32x2*)(ORAW + base + 256 + 4 * lane);
            r0[h] = *(const u32x2*)(Rg + base + 4 * lane); r1[h] = *(const u32x2*)(Rg + base + 256 + 4 * lane); }
#pragma unroll
        for (int h = 0; h < 8; ++h) { const size_t base = rb + h * 512;
            const f32x4 v0 = (f32x4){bflo(q0[h].x), bfhi(q0[h].x), bflo(q0[h].y), bfhi(q0[h].y)}, v1 = (f32x4){bflo(q1[h].x), bfhi(q1[h].x), bflo(q1[h].y), bfhi(q1[h].y)};
            const float s = (v0.x * v0.x + v0.y * v0.y) + (v0.z * v0.z + v0.w * v0.w) + (v1.x * v1.x + v1.y * v1.y) + (v1.z * v1.z + v1.w * v1.w);
            const float rstd = 1.0f / sqrtf(wave_sum(s) * (1.0f / 512.0f) + RMS_EPS);
            float rr[8] = {bflo(r0[h].x), bfhi(r0[h].x), bflo(r0[h].y), bfhi(r0[h].y), bflo(r1[h].x), bfhi(r1[h].x), bflo(r1[h].y), bfhi(r1[h].y)};
#pragma unroll
            for (int e = 0; e < 8; ++e) rr[e] = rr[e] / (1.0f + __expf(-rr[e]));
            u32x2 o0, o1;
            o0.x = pk2(v0.x * rstd * g0.x * rr[0], v0.y * rstd * g0.y * rr[1]); o0.y = pk2(v0.z * rstd * g0.z * rr[2], v0.w * rstd * g0.w * rr[3]);
            o1.x = pk2(v1.x * rstd * g1.x * rr[4], v1.y * rstd * g1.y * rr[5]); o1.y = pk2(v1.z * rstd * g1.z * rr[6], v1.w * rstd * g1.w * rr[7]);
            *(u32x2*)(OG + base + 4 * lane) = o0; *(u32x2*)(OG + base + 256 + 4 * lane) = o1; }
    }
}

template <bool F8OUT> __device__ __forceinline__ void conv_fixup(const bf16_t* UH, const float* cw, const float* cb, bf16_t* ACT, int gtid, int ngt) {
    constexpr int NV = DFF / 8;
    for (int idx = gtid; idx < (M / 64) * NV; idx += ngt) {
        const int g = idx / NV, cv = idx - g * NV, c = 8 * cv, pn = c >> 7, l = c & 127;
        const bool first = (g & 127) == 0;
        float a[2][8];
        float y[2][2][8];
#pragma unroll
        for (int half = 0; half < 2; ++half) {
            const int cc = c + half * DFF; const size_t hc = (size_t)pn * 256 + half * 128 + l;
            float um2[8], um1[8], u0[8], u1[8];
            const u32x4 z = (u32x4){0u, 0u, 0u, 0u};
            const u32x4 q2 = first ? z : *(const u32x4*)(UH + ((size_t)(g - 1) * 4 + 0) * DFF2 + hc), q1 = first ? z : *(const u32x4*)(UH + ((size_t)(g - 1) * 4 + 1) * DFF2 + hc);
            const u32x4 p0 = *(const u32x4*)(UH + ((size_t)g * 4 + 2) * DFF2 + hc), p1 = *(const u32x4*)(UH + ((size_t)g * 4 + 3) * DFF2 + hc);
            const unsigned q2a[4] = {q2.x, q2.y, q2.z, q2.w}, q1a[4] = {q1.x, q1.y, q1.z, q1.w}, p0a[4] = {p0.x, p0.y, p0.z, p0.w}, p1a[4] = {p1.x, p1.y, p1.z, p1.w};
#pragma unroll
            for (int e2 = 0; e2 < 4; ++e2) { um2[2 * e2] = bflo(q2a[e2]); um2[2 * e2 + 1] = bfhi(q2a[e2]); um1[2 * e2] = bflo(q1a[e2]); um1[2 * e2 + 1] = bfhi(q1a[e2]);
                u0[2 * e2] = bflo(p0a[e2]); u0[2 * e2 + 1] = bfhi(p0a[e2]); u1[2 * e2] = bflo(p1a[e2]); u1[2 * e2 + 1] = bfhi(p1a[e2]); }
#pragma unroll
            for (int e = 0; e < 8; ++e) { const float w0 = cw[cc + e], w1 = cw[DFF2 + cc + e], w2 = cw[2 * DFF2 + cc + e], bb = cb[cc + e];
                y[0][half][e] = bb + w0 * um2[e] + w1 * um1[e] + w2 * u0[e];
                y[1][half][e] = bb + w0 * um1[e] + w1 * u0[e] + w2 * u1[e]; }
        }
#pragma unroll
        for (int r = 0; r < 2; ++r) {
#pragma unroll
            for (int e = 0; e < 8; ++e) a[r][e] = y[r][0][e] / (1.0f + __expf(-y[r][0][e])) * y[r][1][e];
            if (F8OUT) { u32x2 o; o.x = pack4_fp8(a[r][0] * ACT_SC, a[r][1] * ACT_SC, a[r][2] * ACT_SC, a[r][3] * ACT_SC); o.y = pack4_fp8(a[r][4] * ACT_SC, a[r][5] * ACT_SC, a[r][6] * ACT_SC, a[r][7] * ACT_SC);
                *(u32x2*)((unsigned char*)ACT + (size_t)(64 * g + r) * DFF + c) = o; }
            else { u32x4 o; o.x = pk2(a[r][0], a[r][1]); o.y = pk2(a[r][2], a[r][3]); o.z = pk2(a[r][4], a[r][5]); o.w = pk2(a[r][6], a[r][7]);
                *(u32x4*)(ACT + (size_t)(64 * g + r) * DFF + c) = o; } }
    }
}

__device__ __forceinline__ void dsa_norm(const float* Z, const float* g_q, const float* g_kv, bf16_t* CQN, unsigned char* CQN8, bf16_t* CKV, bf16_t* KIDX, float* WIDX, int gw, int NGW, int lane) {
    f32x4 gq[4], gk[2];
#pragma unroll
    for (int j = 0; j < 4; ++j) gq[j] = *(const f32x4*)(g_q + 4 * (lane + 64 * j));
#pragma unroll
    for (int j = 0; j < 2; ++j) gk[j] = *(const f32x4*)(g_kv + 4 * (lane + 64 * j));
    f32x4 nq[4], nkv[2], nk = (f32x4){0.f, 0.f, 0.f, 0.f}, nw = nk;
#define DSA_LOADROW(mm) do { const float* z_ = Z + (size_t)(mm) * DSA_IN_NP; _Pragma("unroll") for (int j = 0; j < 4; ++j) nq[j] = *(const f32x4*)(z_ + 4 * (lane + 64 * j)); \
        _Pragma("unroll") for (int j = 0; j < 2; ++j) nkv[j] = *(const f32x4*)(z_ + 1024 + 4 * (lane + 64 * j)); \
        nk = *(const f32x4*)(z_ + 1536 + 4 * (lane & 31)); nw = *(const f32x4*)(z_ + 1664 + 4 * (lane & 15)); } while (0)
    if (gw < M) DSA_LOADROW(gw);
    for (int m = gw; m < M; m += NGW) {
        f32x4 q[4], kv[2]; const f32x4 k = nk, wv = nw; float s = 0.f, s2 = 0.f;
#pragma unroll
        for (int j = 0; j < 4; ++j) { q[j] = nq[j]; s += (q[j].x * q[j].x + q[j].y * q[j].y) + (q[j].z * q[j].z + q[j].w * q[j].w); }
#pragma unroll
        for (int j = 0; j < 2; ++j) { kv[j] = nkv[j]; s2 += (kv[j].x * kv[j].x + kv[j].y * kv[j].y) + (kv[j].z * kv[j].z + kv[j].w * kv[j].w); }
        if (m + NGW < M) DSA_LOADROW(m + NGW);
        const float rq = 1.0f / sqrtf(wave_sum(s) * (1.0f / 1024.0f) + RMS_EPS);
#pragma unroll
        for (int j = 0; j < 4; ++j) { const f32x4 gg = gq[j]; const float o0 = q[j].x * rq * gg.x, o1 = q[j].y * rq * gg.y, o2 = q[j].z * rq * gg.z, o3 = q[j].w * rq * gg.w;
            u32x2 w; w.x = pk2(o0, o1); w.y = pk2(o2, o3); *(u32x2*)(CQN + (size_t)m * 1024 + 4 * (lane + 64 * j)) = w;
            *(unsigned*)(CQN8 + (size_t)m * 1024 + 4 * (lane + 64 * j)) = pack4_fp8(o0 * CQ_SC, o1 * CQ_SC, o2 * CQ_SC, o3 * CQ_SC); }
        const float rk = 1.0f / sqrtf(wave_sum(s2) * (1.0f / 512.0f) + RMS_EPS);
#pragma unroll
        for (int j = 0; j < 2; ++j) { const f32x4 gg = gk[j]; u32x2 w; w.x = pk2(kv[j].x * rk * gg.x, kv[j].y * rk * gg.y); w.y = pk2(kv[j].z * rk * gg.z, kv[j].w * rk * gg.w);
            *(u32x2*)(CKV + (size_t)m * 512 + 4 * (lane + 64 * j)) = w; }
        if (lane < 32) { u32x2 w; w.x = pk2(k.x, k.y); w.y = pk2(k.z, k.w); *(u32x2*)(KIDX + (size_t)m * 128 + 4 * lane) = w; }
        if (lane < 16) { *(f32x4*)(WIDX + (size_t)m * 64 + 4 * lane) = wv * 0.01104854345603981f; }
    }
#undef DSA_LOADROW
}

constexpr int IX_PITCH = 272, IX_BUF = 64 * IX_PITCH;
__device__ __forceinline__ void indexer_group(int u, const bf16_t* QIDX, const bf16_t* KIDX, const float* WIDX, float* SCo, LAS unsigned char* lds, int tid) {
    const int lane = tid & 63, w = __builtin_amdgcn_readfirstlane(tid >> 6), fr = lane & 15, fq = lane >> 4;
    const int m0 = 16 * u, b = m0 >> 13, t0 = m0 & (SEQ - 1);
    if (t0 + 15 < 256) return;
    const int ng = (t0 + 15 + 64) >> 6;
    const int mA = m0 + 2 * w;
    bf16x8 a[2][4][4]; f32x4 wv[2][4]; bf16x8 abar[4];
#pragma unroll
    for (int ks = 0; ks < 4; ++ks) abar[ks] = (bf16x8){0, 0, 0, 0, 0, 0, 0, 0};
#pragma unroll
    for (int tk = 0; tk < 2; ++tk) {
        float qs[4][8];
#pragma unroll
        for (int ks = 0; ks < 4; ++ks)
#pragma unroll
            for (int e = 0; e < 8; ++e) qs[ks][e] = 0.f;
#pragma unroll
        for (int mt = 0; mt < 4; ++mt) {
            const float wrow = 0.5f * WIDX[(size_t)(mA + tk) * 64 + 16 * mt + fr];
#pragma unroll
            for (int ks = 0; ks < 4; ++ks) { a[tk][mt][ks] = *(const bf16x8*)(QIDX + (size_t)(mA + tk) * 8192 + (16 * mt + fr) * 128 + 32 * ks + 8 * fq);
                const u32x4 aw = __builtin_bit_cast(u32x4, a[tk][mt][ks]);
                qs[ks][0] += wrow * bflo(aw.x); qs[ks][1] += wrow * bfhi(aw.x); qs[ks][2] += wrow * bflo(aw.y); qs[ks][3] += wrow * bfhi(aw.y);
                qs[ks][4] += wrow * bflo(aw.z); qs[ks][5] += wrow * bfhi(aw.z); qs[ks][6] += wrow * bflo(aw.w); qs[ks][7] += wrow * bfhi(aw.w); }
            wv[tk][mt] = *(const f32x4*)(WIDX + (size_t)(mA + tk) * 64 + 16 * mt + 4 * fq) * 0.5f; }
#pragma unroll
        for (int ks = 0; ks < 4; ++ks) {
#pragma unroll
            for (int e = 0; e < 8; ++e) { float v = qs[ks][e];
                v += __builtin_bit_cast(float, __builtin_amdgcn_update_dpp(0, __builtin_bit_cast(int, v), 0xB1, 0xf, 0xf, false));
                v += __builtin_bit_cast(float, __builtin_amdgcn_update_dpp(0, __builtin_bit_cast(int, v), 0x4E, 0xf, 0xf, false));
                v += __builtin_bit_cast(float, __builtin_amdgcn_update_dpp(0, __builtin_bit_cast(int, v), 0x141, 0xf, 0xf, false));
                v += __builtin_bit_cast(float, __builtin_amdgcn_update_dpp(0, __builtin_bit_cast(int, v), 0x140, 0xf, 0xf, false));
                qs[ks][e] = v; }
            const u32x4 pkd = (u32x4){pk2(qs[ks][0], qs[ks][1]), pk2(qs[ks][2], qs[ks][3]), pk2(qs[ks][4], qs[ks][5]), pk2(qs[ks][6], qs[ks][7])};
            if (fr == tk) abar[ks] = __builtin_bit_cast(bf16x8, pkd); }
    }
    const int krow = tid >> 3, kc = (tid & 7) * 2;
    const bf16_t* kp = KIDX + ((size_t)b * SEQ + krow) * 128 + kc * 8;
    u32x4 r0 = *(const u32x4*)kp, r1 = *(const u32x4*)(kp + 8);
    *(LAS u32x4*)(lds + krow * IX_PITCH + kc * 16) = r0; *(LAS u32x4*)(lds + krow * IX_PITCH + kc * 16 + 16) = r1;
    __syncthreads();
    for (int g = 0; g < ng; ++g) {
        if (g + 1 < ng) { const bf16_t* kn = kp + (size_t)(g + 1) * 64 * 128; r0 = *(const u32x4*)kn; r1 = *(const u32x4*)(kn + 8); }
        const LAS unsigned char* cur = lds + (g & 1) * IX_BUF;
        float p[2][4];
        bf16x8 bb[4];
#pragma unroll
        for (int ks = 0; ks < 4; ++ks) bb[ks] = *(const LAS bf16x8*)(cur + fr * IX_PITCH + (4 * ks + fq) * 16);
#pragma unroll
        for (int nt = 0; nt < 4; ++nt) {
            float pn[2] = {0.f, 0.f};
            f32x4 acc[5][2];
#pragma unroll
            for (int st = 0; st < 24; ++st) {
                if (st < 20) { const int q = st >> 2, ks = st & 3;
#pragma unroll
                    for (int j = 0; j < 2; ++j) { const int ch = 2 * q + j; if (ch < 9) {
                        const bf16x8 af = ch == 0 ? abar[ks] : a[(ch - 1) >> 2][(ch - 1) & 3][ks];
                        acc[q][j] = mfma16(af, bb[ks], ks ? acc[q][j] : (f32x4){0.f, 0.f, 0.f, 0.f}); } }
                }
                if (st >= 4) { const int q = (st - 4) >> 2, el = (st - 4) & 3;
#pragma unroll
                    for (int j = 0; j < 2; ++j) { const int ch = 2 * q + j; if (ch < 9) {
                        if (ch == 0) { if (el < 2) pn[el] = fq == 0 ? acc[0][0][el] : 0.f; }
                        else { const int tk = (ch - 1) >> 2, mt = (ch - 1) & 3; pn[tk] = __builtin_fmaf(__builtin_fabsf(acc[q][j][el]), wv[tk][mt][el], pn[tk]); } } }
                }
                if (st == 20 && nt < 3) {
#pragma unroll
                    for (int k2 = 0; k2 < 4; ++k2) bb[k2] = *(const LAS bf16x8*)(cur + (16 * (nt + 1) + fr) * IX_PITCH + (4 * k2 + fq) * 16); }
                __builtin_amdgcn_sched_barrier(0);
            }
            p[0][nt] = pn[0]; p[1][nt] = pn[1];
        }
#pragma unroll
        for (int tk = 0; tk < 2; ++tk) {
            const float k0 = swapsum32(p[tk][0], p[tk][2]), k1 = swapsum32(p[tk][1], p[tk][3]);
            const float keep = swapsum16(k0, k1);
            SCo[(size_t)(mA + tk) * SEQ + 64 * g + lane] = keep; }
        if (g + 1 < ng) { LAS unsigned char* nx = lds + ((g + 1) & 1) * IX_BUF; *(LAS u32x4*)(nx + krow * IX_PITCH + kc * 16) = r0; *(LAS u32x4*)(nx + krow * IX_PITCH + kc * 16 + 16) = r1; }
        __syncthreads();
    }
}

__device__ __forceinline__ unsigned ord_key(float f) { const unsigned u = __builtin_bit_cast(unsigned, f); return u ^ ((u >> 31) ? 0xFFFFFFFFu : 0x80000000u); }
__device__ __forceinline__ int wave_sum_i(int v) {
    v += __builtin_amdgcn_update_dpp(0, v, 0xB1, 0xf, 0xf, false);
    v += __builtin_amdgcn_update_dpp(0, v, 0x4E, 0xf, 0xf, false);
    v += __builtin_amdgcn_update_dpp(0, v, 0x141, 0xf, 0xf, false);
    v += __builtin_amdgcn_update_dpp(0, v, 0x140, 0xf, 0xf, false);
    return __builtin_amdgcn_readlane(v, 0) + __builtin_amdgcn_readlane(v, 16) + __builtin_amdgcn_readlane(v, 32) + __builtin_amdgcn_readlane(v, 48);
}
__device__ __forceinline__ void topk_token(int m, const float* SCi, int* SEL, int lane) {
    const int t = m & (SEQ - 1), n = t + 1; int* sel = SEL + (size_t)m * 256;
    if (n <= 256) {
#pragma unroll
        for (int j = 0; j < 4; ++j) { const int i = lane + 64 * j; sel[i] = i < n ? i : -1; }
        return; }
    const float* sc = SCi + (size_t)m * SEQ;
    const int nq = (n + 255) >> 8;
    unsigned key[32][4];
    f32x4 raw[32];
#pragma unroll
    for (int j = 0; j < 32; ++j) raw[j] = *(const f32x4*)(sc + 256 * (j < nq ? j : 0) + 4 * lane);
#pragma unroll
    for (int j = 0; j < 32; ++j) { const int i0 = 256 * j + 4 * lane;
        key[j][0] = i0 < n ? ord_key(raw[j].x) : 0u; key[j][1] = i0 + 1 < n ? ord_key(raw[j].y) : 0u; key[j][2] = i0 + 2 < n ? ord_key(raw[j].z) : 0u; key[j][3] = i0 + 3 < n ? ord_key(raw[j].w) : 0u; }
    unsigned prefix = 0u;
#pragma unroll 1
    for (int bit = 31; bit >= 0; --bit) {
        const unsigned cand = prefix | (1u << bit); int cnt = 0; int cntv = 0;
#pragma unroll
        for (int jg = 0; jg < 4; ++jg) if (8 * jg < nq) {
#pragma unroll
            for (int j = 8 * jg; j < 8 * jg + 8; j += 2) {
                unsigned long long bm[5];
#pragma unroll
                for (int e = 0; e < 3; ++e) bm[e] = __ballot(key[j][e] >= cand);
                bm[3] = __ballot(key[j + 1][0] >= cand); bm[4] = __ballot(key[j + 1][1] >= cand);
                asm("v_cmp_le_u32 vcc, %1, %2\n\tv_addc_co_u32 %0, vcc, 0, %0, vcc" : "+v"(cntv) : "s"(cand), "v"(key[j][3]) : "vcc");
                asm("v_cmp_le_u32 vcc, %1, %2\n\tv_addc_co_u32 %0, vcc, 0, %0, vcc" : "+v"(cntv) : "s"(cand), "v"(key[j + 1][2]) : "vcc");
                asm("v_cmp_le_u32 vcc, %1, %2\n\tv_addc_co_u32 %0, vcc, 0, %0, vcc" : "+v"(cntv) : "s"(cand), "v"(key[j + 1][3]) : "vcc");
                __builtin_amdgcn_sched_barrier(0);
#pragma unroll
                for (int e = 0; e < 5; ++e) cnt += __builtin_popcountll(bm[e]);
                __builtin_amdgcn_sched_barrier(0); } }
        cnt += wave_sum_i(cntv);
        if (cnt >= 256) { prefix = cand; if (cnt == 256) break; }
    }
    const unsigned T = prefix;
    int cgts = 0;
#pragma unroll
    for (int jg = 0; jg < 4; ++jg) if (8 * jg < nq) {
#pragma unroll
        for (int j = 8 * jg; j < 8 * jg + 8; ++j)
#pragma unroll
            for (int e = 0; e < 4; ++e) cgts += __builtin_popcountll(__ballot(key[j][e] > T)); }
    const int want = 256 - cgts;
    int base = 0, eqtaken = 0;
    const unsigned long long ltmask = (1ull << lane) - 1ull;
#pragma unroll
    for (int j = 0; j < 32; ++j) if (j < nq) {
        const bool e0 = key[j][0] == T, e1 = key[j][1] == T, e2 = key[j][2] == T, e3 = key[j][3] == T;
        const int ecl = (int)e0 + (int)e1 + (int)e2 + (int)e3;
        const unsigned long long anyeq = __ballot(ecl != 0);
        int eqlow = 0, eqall = 0;
        if (anyeq) { int x = ecl;
#pragma unroll
            for (int off = 1; off < 64; off <<= 1) { const int y = __shfl_up(x, off); if (lane >= off) x += y; }
            eqlow = x - ecl; eqall = __shfl(x, 63); }
        const int r0 = eqtaken + eqlow;
        const bool t0 = key[j][0] > T || (e0 && r0 < want);
        const bool t1 = key[j][1] > T || (e1 && r0 + (int)e0 < want);
        const bool t2 = key[j][2] > T || (e2 && r0 + (int)e0 + (int)e1 < want);
        const bool t3 = key[j][3] > T || (e3 && r0 + (int)e0 + (int)e1 + (int)e2 < want);
        const unsigned long long b0 = __ballot(t0), b1 = __ballot(t1), b2 = __ballot(t2), b3 = __ballot(t3);
        const int i0 = 256 * j + 4 * lane; int pos = base + __builtin_popcountll(b0 & ltmask);
        if (t0 && pos < 256) sel[pos] = i0;
        base += __builtin_popcountll(b0); pos = base + __builtin_popcountll(b1 & ltmask);
        if (t1 && pos < 256) sel[pos] = i0 + 1;
        base += __builtin_popcountll(b1); pos = base + __builtin_popcountll(b2 & ltmask);
        if (t2 && pos < 256) sel[pos] = i0 + 2;
        base += __builtin_popcountll(b2); pos = base + __builtin_popcountll(b3 & ltmask);
        if (t3 && pos < 256) sel[pos] = i0 + 3;
        base += __builtin_popcountll(b3); eqtaken += eqall;
    }
}

template <int KSTEPS, int NB>
__device__ __forceinline__ void thin_gemm_wave(const bf16_t* A, size_t lda, const bf16_t* Bt, bf16_t* C, size_t ldc, int lane) {
    const int fr = lane & 15, fq = lane >> 4; constexpr int K = 32 * KSTEPS;
    bf16x8 a[2][KSTEPS];
#pragma unroll
    for (int mi = 0; mi < 2; ++mi)
#pragma unroll
        for (int ks = 0; ks < KSTEPS; ++ks) a[mi][ks] = *(const bf16x8*)(A + (size_t)(16 * mi + fr) * lda + 32 * ks + 8 * fq);
    for (int nt = 0; nt < NB * 4; ++nt) {
        f32x4 acc0 = (f32x4){0.f, 0.f, 0.f, 0.f}, acc1 = acc0;
        const bf16_t* bp = Bt + (size_t)(16 * nt + fr) * K + 8 * fq;
#pragma unroll
        for (int ks = 0; ks < KSTEPS; ++ks) { const bf16x8 bb = *(const bf16x8*)(bp + 32 * ks); acc0 = mfma16(bb, a[0][ks], acc0); acc1 = mfma16(bb, a[1][ks], acc1); }
        u32x2 w0, w1; w0.x = pk2(acc0[0], acc0[1]); w0.y = pk2(acc0[2], acc0[3]); w1.x = pk2(acc1[0], acc1[1]); w1.y = pk2(acc1[2], acc1[3]);
        *(u32x2*)(C + (size_t)fr * ldc + 16 * nt + 4 * fq) = w0; *(u32x2*)(C + (size_t)(16 + fr) * ldc + 16 * nt + 4 * fq) = w1;
    }
}

constexpr int AT_PITCH = 1056, AT_BUF = 32 * AT_PITCH, AT_QOFF = 2 * AT_BUF, AT_XOFF = AT_QOFF + 64 * AT_PITCH;
static_assert(AT_XOFF + 8192 <= MISC_OFF, "attention LDS map");
__device__ __forceinline__ void attn_q_dma(const bf16_t* QLAT, int m, LAS unsigned char* lds, int w, int lane) {
#pragma unroll
    for (int i = 0; i < 8; ++i) { const unsigned char* src = (const unsigned char*)QLAT + (size_t)m * 65536 + (8 * w + i) * 512 + lane * 4; LAS unsigned char* dst = lds + AT_QOFF + (8 * w + i) * AT_PITCH;
        __builtin_amdgcn_global_load_lds((const unsigned*)src, (LAS unsigned*)dst, 4, 0, 0); __builtin_amdgcn_global_load_lds((const unsigned*)(src + 256), (LAS unsigned*)(dst + 256), 4, 0, 0); }
}
__device__ __forceinline__ bf16x8 fp8x8_to_bf16(u32x2 r) {
    const auto a = __builtin_amdgcn_cvt_pk_f32_fp8((int)r.x, false), b2 = __builtin_amdgcn_cvt_pk_f32_fp8((int)r.x, true), c2 = __builtin_amdgcn_cvt_pk_f32_fp8((int)r.y, false), d = __builtin_amdgcn_cvt_pk_f32_fp8((int)r.y, true);
    u32x4 w; w.x = pg8::cvt_pk_bf16(a[0], a[1]); w.y = pg8::cvt_pk_bf16(b2[0], b2[1]); w.z = pg8::cvt_pk_bf16(c2[0], c2[1]); w.w = pg8::cvt_pk_bf16(d[0], d[1]);
    return __builtin_bit_cast(bf16x8, w);
}
__device__ __forceinline__ void attn_fetch32(u32x4 (&g)[4], int selreg, int half, int b, const bf16_t* CKV, int w, int lane) {
#pragma unroll
    for (int i = 0; i < 4; ++i) { const int idx = __builtin_amdgcn_readlane(selreg, 32 * half + 4 * w + i);
        g[i] = *(const u32x4*)(CKV + ((size_t)b * SEQ + idx) * 512 + lane * 8); }
}
__device__ __forceinline__ void attn_put32(const u32x4 (&g)[4], int bufi, LAS unsigned char* lds, int w, int lane) {
#pragma unroll
    for (int i = 0; i < 4; ++i) *(LAS u32x4*)(lds + bufi * AT_BUF + (4 * w + i) * AT_PITCH + lane * 16) = g[i];
}
__device__ __forceinline__ void attn_load_sel(int (&s)[4], int m, const int* SEL, int lane) {
    const int t = m & (SEQ - 1), n = (t + 1 < 256) ? t + 1 : 256;
#pragma unroll
    for (int j = 0; j < 4; ++j) { const int ki = 64 * j + lane; const int v = ki < n ? SEL[(size_t)m * 256 + ki] : 0; s[j] = ((unsigned)v < (unsigned)SEQ) ? v : 0; }
}
__device__ __forceinline__ void attn_stream(int blk, int G, bf16_t* QLAT, const bf16_t* CKV, const int* SEL, LAS unsigned char* lds, int tid) {
    const int lane = tid & 63, w = __builtin_amdgcn_readfirstlane(tid >> 6), fr = lane & 15, fq = lane >> 4;
    const int ht = w & 3, chalf = w >> 2;
    const bool xl = (G == 256); const int nT = xl ? 64 : (M - blk + G - 1) / G;
#define AT_TOK(i) (xl ? ((((i) >> 5) << 13) + ((blk & 7) << 10) + (((i) & 31) << 5) + (blk >> 3)) : (blk + (i) * G))
    int scur[4], snext[4];
    attn_load_sel(scur, AT_TOK(0), SEL, lane);
    if (nT > 1) attn_load_sel(snext, AT_TOK(1), SEL, lane); else { snext[0] = 0; snext[1] = 0; snext[2] = 0; snext[3] = 0; }
    bf16x8 qa[16];
    attn_q_dma(QLAT, AT_TOK(0), lds, w, lane);
    { u32x4 g0[4]; attn_fetch32(g0, scur[0], 0, AT_TOK(0) >> 13, CKV, w, lane); attn_put32(g0, 0, lds, w, lane); }
    asm volatile("s_waitcnt vmcnt(0)" ::: "memory");
    __syncthreads();
    const int ii = lane & 15, tq = ii >> 2, tp = ii & 3;
    for (int i = 0; i < nT; ++i) {
        const int m = AT_TOK(i), mn = AT_TOK(i + 1), t = m & (SEQ - 1), n = (t + 1 < 256) ? t + 1 : 256;
        const bool more = i + 1 < nT;
        f32x4 o[16];
#pragma unroll
        for (int c = 0; c < 16; ++c) o[c] = (f32x4){0.f, 0.f, 0.f, 0.f};
        float mrun = -3.0e38f, lrun = 0.f;
#pragma unroll
        for (int ks = 0; ks < 16; ++ks) qa[ks] = fp8x8_to_bf16(*(const LAS u32x2*)(lds + AT_QOFF + (16 * ht + fr) * AT_PITCH + 32 * ks + 8 * fq));
#pragma unroll
        for (int kb = 0; kb < 8; ++kb) {
            u32x4 g[4];
            if (kb == 1 && more) attn_q_dma(QLAT, mn, lds, w, lane);
            if (kb < 7) attn_fetch32(g, scur[(kb + 1) >> 1], (kb + 1) & 1, m >> 13, CKV, w, lane);
            else if (more) attn_fetch32(g, snext[0], 0, mn >> 13, CKV, w, lane);
            const LAS unsigned char* cur = lds + (kb & 1) * AT_BUF;
            if (32 * kb < n) {
                f32x4 own = (f32x4){0.f, 0.f, 0.f, 0.f};
                { bf16x8 cf[2][8];
#pragma unroll
                  for (int j = 0; j < 8; ++j) cf[0][j] = lfrag(cur, 16 * chalf + fr, AT_PITCH, 32 * j + 8 * fq);
#pragma unroll
                  for (int j = 0; j < 8; ++j) cf[1][j] = lfrag(cur, 16 * chalf + fr, AT_PITCH, 32 * (8 + j) + 8 * fq);
                  __builtin_amdgcn_sched_barrier(0);
#pragma unroll
                  for (int j = 0; j < 8; ++j) own = mfma16(cf[0][j], qa[j], own);
#pragma unroll
                  for (int j = 0; j < 8; ++j) own = mfma16(cf[1][j], qa[8 + j], own); }
                *(LAS f32x4*)(lds + AT_XOFF + (w * 64 + lane) * 16) = own;
                __syncthreads();
                const f32x4 oth = *(const LAS f32x4*)(lds + AT_XOFF + ((w ^ 4) * 64 + lane) * 16);
                f32x4 acc[2]; acc[0] = chalf == 0 ? own : oth; acc[1] = chalf == 0 ? oth : own;
                constexpr float KS = 0.08838834764831845f * 1.4426950408889634f / QL_SC;
                float mloc = -3.0e38f; const int lim = n - 32 * kb - 4 * fq;
                const bool full = n - 32 * kb >= 32;
                if (full) {
#pragma unroll
                    for (int km = 0; km < 2; ++km)
#pragma unroll
                        for (int r = 0; r < 4; ++r) { acc[km][r] *= KS; mloc = fmaxf(mloc, acc[km][r]); }
                } else {
#pragma unroll
                    for (int km = 0; km < 2; ++km)
#pragma unroll
                        for (int r = 0; r < 4; ++r) { const float sv = (16 * km + r) < lim ? acc[km][r] * KS : -3.0e38f; acc[km][r] = sv; mloc = fmaxf(mloc, sv); }
                }
                mloc = xmax_rows(mloc);
                const bool up = mloc > mrun + 11.0f;
                if (__any(up)) { const float mnew = up ? mloc : mrun, alpha = __builtin_amdgcn_exp2f(mrun - mnew); mrun = mnew; lrun *= alpha;
#pragma unroll
                    for (int c = 0; c < 16; ++c) o[c] = o[c] * alpha; }
                float ls = 0.f;
#pragma unroll
                for (int km = 0; km < 2; ++km)
#pragma unroll
                    for (int r = 0; r < 4; ++r) { const float pv = __builtin_amdgcn_exp2f(acc[km][r] - mrun); acc[km][r] = pv; ls += pv; }
                lrun += ls;
                const unsigned p0 = pg8::cvt_pk_bf16(acc[0][0], acc[0][1]), p1 = pg8::cvt_pk_bf16(acc[0][2], acc[0][3]), p2 = pg8::cvt_pk_bf16(acc[1][0], acc[1][1]), p3 = pg8::cvt_pk_bf16(acc[1][2], acc[1][3]);
                const bf16x8 pb = __builtin_bit_cast(bf16x8, (u32x4){p0, p1, p2, p3});
                const unsigned trb = (unsigned)(uintptr_t)(cur + (4 * fq + tq) * AT_PITCH + (256 * chalf + 4 * tp) * 2);
#define AT_TRRD(dst, off) asm volatile("ds_read_b64_tr_b16 %0, %1 offset:%2" : "=&v"(dst) : "v"(trb), "i"(off) : "memory")
#define AT_TRGRP(L, H, cg) do { AT_TRRD(L[0], 128 * (cg)); AT_TRRD(H[0], 128 * (cg) + 16 * AT_PITCH); AT_TRRD(L[1], 128 * (cg) + 32); AT_TRRD(H[1], 128 * (cg) + 32 + 16 * AT_PITCH); \
                    AT_TRRD(L[2], 128 * (cg) + 64); AT_TRRD(H[2], 128 * (cg) + 64 + 16 * AT_PITCH); AT_TRRD(L[3], 128 * (cg) + 96); AT_TRRD(H[3], 128 * (cg) + 96 + 16 * AT_PITCH); } while (0)
#define AT_TRWAIT(L, H, n) asm volatile("s_waitcnt lgkmcnt(" #n ")" : "+v"(L[0]), "+v"(L[1]), "+v"(L[2]), "+v"(L[3]), "+v"(H[0]), "+v"(H[1]), "+v"(H[2]), "+v"(H[3]) :: "memory")
#define AT_PVMMA(L, H, cg) do { _Pragma("unroll") for (int j = 0; j < 4; ++j) o[4 * (cg) + j] = mfma16((bf16x8){L[j][0], L[j][1], L[j][2], L[j][3], H[j][0], H[j][1], H[j][2], H[j][3]}, pb, o[4 * (cg) + j]); } while (0)
                { s16x4 la[4], ha[4], lb[4], hb[4];
                  AT_TRGRP(la, ha, 0); AT_TRGRP(lb, hb, 1);
                  AT_TRWAIT(la, ha, 8); __builtin_amdgcn_sched_barrier(0); AT_PVMMA(la, ha, 0); __builtin_amdgcn_sched_barrier(0);
                  AT_TRGRP(la, ha, 2);
                  AT_TRWAIT(lb, hb, 8); __builtin_amdgcn_sched_barrier(0); AT_PVMMA(lb, hb, 1); __builtin_amdgcn_sched_barrier(0);
                  AT_TRGRP(lb, hb, 3);
                  AT_TRWAIT(la, ha, 8); __builtin_amdgcn_sched_barrier(0); AT_PVMMA(la, ha, 2); __builtin_amdgcn_sched_barrier(0);
                  AT_TRWAIT(lb, hb, 0); __builtin_amdgcn_sched_barrier(0); AT_PVMMA(lb, hb, 3); }
#undef AT_TRGRP
#undef AT_TRWAIT
#undef AT_PVMMA
#undef AT_TRRD
            }
            if (kb == 7) {
                const float inv = OL_SC / xsum_rows(lrun);
                unsigned char* orow = (unsigned char*)QLAT + (size_t)m * 65536 + (16 * ht + fr) * 512 + 256 * chalf + 4 * fq;
#pragma unroll
                for (int tt = 0; tt < 16; ++tt) *(unsigned*)(orow + 16 * tt) = pack4_fp8(o[tt][0] * inv, o[tt][1] * inv, o[tt][2] * inv, o[tt][3] * inv);
                if (more) {
                    scur[0] = snext[0]; scur[1] = snext[1]; scur[2] = snext[2]; scur[3] = snext[3];
                    if (i + 2 < nT) attn_load_sel(snext, AT_TOK(i + 2), SEL, lane); }
            }
            if (kb < 7 || more) attn_put32(g, (kb + 1) & 1, lds, w, lane);
            __syncthreads();
        }
    }
#undef AT_TOK
}

#ifndef MK_ONE_LAUNCH
#define MK_ONE_LAUNCH 1
#endif
constexpr int NPH = 25;
struct Args { const float* in[20]; float* out; unsigned char* ws; int ph_lo, ph_hi; };

__global__ void __launch_bounds__(NTHR, 2) fwd(Args args) {
    extern __shared__ __attribute__((aligned(16))) unsigned char lds_raw[];
    LAS unsigned char* lds = (LAS unsigned char*)lds_raw;
    volatile LAS unsigned* MISC = (volatile LAS unsigned*)(lds + MISC_OFF);
    const int G = gridDim.x, blk = blockIdx.x, NGW = G * NWAVES;
    const int wave0 = __builtin_amdgcn_readfirstlane((int)threadIdx.x >> 6);
#define PH_IDS const int lane = hw_lane(), wave = wave0, tid = wave * 64 + lane, gw = blk * NWAVES + wave; (void)tid; (void)gw;
    unsigned char* ws = args.ws;
    unsigned* ctl = (unsigned*)(ws + WS_CTL);
    { PH_IDS for (int u = tid; u < (LDS_BYTES - MISC_OFF) / 4; u += NTHR) ((LAS unsigned*)(lds + MISC_OFF))[u] = 0u; }
    __syncthreads();
    XcdBarrier bar = xcd_barrier_post(ctl + CW_BAR, MISC + 8);
    const int lo = args.ph_lo, hi = args.ph_hi;
#define IN(k) (lo <= (k) && (k) < hi)
#define SEAM(k) do { if (IN(k) && IN((k) + 1)) xcd_barrier(bar, wave0 == 0 && hw_lane() == 0); } while (0)

    const float* x = args.in[0]; const float* g_mix = args.in[1]; const float* g_ffn = args.in[2]; const float* g_final = args.in[3];
    bf16_t* W_GLA_IN = (bf16_t*)(ws + WS_W_GLA_IN); bf16_t* W_GLA_O = (bf16_t*)(ws + WS_W_GLA_O); bf16_t* W_DSA_IN = (bf16_t*)(ws + WS_W_DSA_IN);
    bf16_t* W_QUP = (bf16_t*)(ws + WS_W_QUP); bf16_t* W_UK = (bf16_t*)(ws + WS_W_UK); bf16_t* W_UV = (bf16_t*)(ws + WS_W_UV); bf16_t* W_DSA_O = (bf16_t*)(ws + WS_W_DSA_O);
    bf16_t* W_UP = (bf16_t*)(ws + WS_W_UP); bf16_t* W_DN = (bf16_t*)(ws + WS_W_DN);
    bf16_t* H = (bf16_t*)(ws + WS_H); bf16_t* HN = (bf16_t*)(ws + WS_HN);

    if (IN(0)) { PH_IDS
        LAS float* scr = (LAS float*)(lds + wave * 16640);
        convert_matrix(args.in[4], 1, 4096, GLA_IN_N, GLA_IN_NP, W_GLA_IN, scr, gw, NGW, lane);
        rmsnorm_rows_bf16(x, g_mix, HN, gw, NGW, lane);
    }
    SEAM(0);
    if (IN(1)) { PH_IDS
        pg8::Gemm g{HN, W_GLA_IN, M, GLA_IN_NP, 4096}; pg8::StaticOrder S; S.init(M, GLA_IN_NP, G, blk);
        pg8::EpiGlaIn E{(bf16_t*)(ws + WS_GQ), (bf16_t*)(ws + WS_GK), (bf16_t*)(ws + WS_GV), (bf16_t*)(ws + WS_GR), (float*)(ws + WS_GA1)};
        pg8::gemm_phase<pg8::EpiGlaIn, pg8::StaticOrder, true, true>(lds, g, S, E, tid);
    }
    SEAM(1);
    if (IN(2)) { PH_IDS
        for (int u = blk; u < 2048; u += G)
            gla_pre_unit(u >> 3, u & 7, (bf16_t*)(ws + WS_GQ), (bf16_t*)(ws + WS_GK), (const float*)(ws + WS_GA1), args.in[5], args.in[6], (bf16_t*)(ws + WS_GKT), (float*)(ws + WS_GEBL), (LAS float*)lds, tid);
    }
    SEAM(2);
    if (IN(3)) { PH_IDS
        if (G >= 256) {
            if (blk < 128) gla_scan_unit(blk >> 6, (blk >> 3) & 7, blk & 7, (const bf16_t*)(ws + WS_GQ), (const bf16_t*)(ws + WS_GK), (const bf16_t*)(ws + WS_GKT), (const bf16_t*)(ws + WS_GV), (const float*)(ws + WS_GEBL), (bf16_t*)(ws + WS_GORAW), lds, tid);
            else { LAS float* scr = (LAS float*)(lds + wave * 16640); const int cgw = (blk - 128) * NWAVES + wave, CNGW = (G - 128) * NWAVES;
        convert_matrix(args.in[8], 1, 4096, 4096, 4096, W_GLA_O, scr, cgw, CNGW, lane);
        convert_matrix(args.in[9], 1, 4096, DSA_IN_N, DSA_IN_NP, W_DSA_IN, scr, cgw, CNGW, lane);
        convert_matrix<false, true>(args.in[12], 1, 1024, 16384, 8192, W_QUP, scr, cgw, CNGW, lane, WQ_SC);
        convert_matrix(args.in[12] + 8192, 1, 1024, 16384, 8192, W_QUP + (size_t)4096 * 1024, scr, cgw, CNGW, lane);
        convert_matrix(args.in[13], 64, 128, 512, 512, W_UK, scr, cgw, CNGW, lane);
        convert_matrix<false, true>(args.in[14], 64, 512, 128, 128, W_UV, scr, cgw, CNGW, lane, WUV_SC);
        convert_matrix<false, true>(args.in[15], 1, 8192, 4096, 4096, W_DSA_O, scr, cgw, CNGW, lane, WO_SC);
        convert_matrix<true>(args.in[16], 1, 4096, DFF2, DFF2, W_UP, scr, cgw, CNGW, lane);
        convert_matrix<true, true>(args.in[16] + (size_t)4096 * DFF2, 1, 4096, DFF2, DFF2, W_UP + (size_t)DFF2 * 4096, scr, cgw, CNGW, lane, WUP_SC);
        convert_matrix(args.in[19], 1, DFF, 4096, 4096, W_DN, scr, cgw, CNGW, lane);
        convert_matrix<false, true>(args.in[19] + (size_t)DFF * 4096, 1, DFF, 4096, 4096, W_DN + (size_t)4096 * DFF, scr, cgw, CNGW, lane, WDN_SC);
            }
        } else {
            for (int u = blk; u < 128; u += G)
                gla_scan_unit(u >> 6, (u >> 3) & 7, u & 7, (const bf16_t*)(ws + WS_GQ), (const bf16_t*)(ws + WS_GK), (const bf16_t*)(ws + WS_GKT), (const bf16_t*)(ws + WS_GV), (const float*)(ws + WS_GEBL), (bf16_t*)(ws + WS_GORAW), lds, tid);
            { LAS float* scr = (LAS float*)(lds + wave * 16640); const int cgw = gw, CNGW = NGW;
        convert_matrix(args.in[8], 1, 4096, 4096, 4096, W_GLA_O, scr, cgw, CNGW, lane);
        convert_matrix(args.in[9], 1, 4096, DSA_IN_N, DSA_IN_NP, W_DSA_IN, scr, cgw, CNGW, lane);
        convert_matrix<false, true>(args.in[12], 1, 1024, 16384, 8192, W_QUP, scr, cgw, CNGW, lane, WQ_SC);
        convert_matrix(args.in[12] + 8192, 1, 1024, 16384, 8192, W_QUP + (size_t)4096 * 1024, scr, cgw, CNGW, lane);
        convert_matrix(args.in[13], 64, 128, 512, 512, W_UK, scr, cgw, CNGW, lane);
        convert_matrix<false, true>(args.in[14], 64, 512, 128, 128, W_UV, scr, cgw, CNGW, lane, WUV_SC);
        convert_matrix<false, true>(args.in[15], 1, 8192, 4096, 4096, W_DSA_O, scr, cgw, CNGW, lane, WO_SC);
        convert_matrix<true>(args.in[16], 1, 4096, DFF2, DFF2, W_UP, scr, cgw, CNGW, lane);
        convert_matrix<true, true>(args.in[16] + (size_t)4096 * DFF2, 1, 4096, DFF2, DFF2, W_UP + (size_t)DFF2 * 4096, scr, cgw, CNGW, lane, WUP_SC);
        convert_matrix(args.in[19], 1, DFF, 4096, 4096, W_DN, scr, cgw, CNGW, lane);
        convert_matrix<false, true>(args.in[19] + (size_t)DFF * 4096, 1, DFF, 4096, 4096, W_DN + (size_t)4096 * DFF, scr, cgw, CNGW, lane, WDN_SC);
            }
        }
    }
    SEAM(3);
    if (IN(4)) { PH_IDS gla_out_norm((const bf16_t*)(ws + WS_GORAW), (const bf16_t*)(ws + WS_GR), args.in[7], (bf16_t*)(ws + WS_GOG), gw, NGW, lane); }
    SEAM(4);
    if (IN(5)) { PH_IDS
        pg8::Gemm g{(const bf16_t*)(ws + WS_GOG), W_GLA_O, M, 4096, 4096}; pg8::StaticOrder S; S.init(M, 4096, G, blk);
        pg8::EpiResBf16<true> E{x, H, 4096};
        pg8::gemm_phase<pg8::EpiResBf16<true>, pg8::StaticOrder, true, true>(lds, g, S, E, tid);
    }
    SEAM(5);
    if (IN(6)) { PH_IDS rmsnorm_rows_from_bf16<false>(H, g_ffn, HN, gw, NGW, lane); }
    SEAM(6);
    if (IN(7)) { PH_IDS
        pg8::Gemm g{HN, W_UP, M, DFF2, 4096}; pg8::StaticOrder S; S.init(M, DFF2, G, blk);
        pg8::EpiConvAct<false> E{(bf16_t*)(ws + WS_ACT), (bf16_t*)(ws + WS_U), args.in[17], args.in[18]};
        pg8::gemm_phase<pg8::EpiConvAct<false>, pg8::StaticOrder, true, true>(lds, g, S, E, tid);
    }
    SEAM(7);
    if (IN(8)) { PH_IDS conv_fixup<false>((const bf16_t*)(ws + WS_U), args.in[17], args.in[18], (bf16_t*)(ws + WS_ACT), blk * NTHR + tid, G * NTHR); }
    SEAM(8);
    if (IN(9)) { PH_IDS
        pg8::Gemm g{(const bf16_t*)(ws + WS_ACT), W_DN, M, 4096, DFF, 0}; pg8::StaticOrder S; S.init(M, 4096, G, blk);
        pg8::EpiResBf16<false> E{H, H, 4096};
        pg8::gemm_phase<pg8::EpiResBf16<false>, pg8::StaticOrder, true, true>(lds, g, S, E, tid);
    }
    SEAM(9);
    if (IN(10)) { PH_IDS rmsnorm_rows_from_bf16<false>(H, g_mix + D, HN, gw, NGW, lane); }
    SEAM(10);
    if (IN(11)) { PH_IDS
        pg8::Gemm g{HN, W_DSA_IN, M, DSA_IN_NP, 4096}; pg8::StaticOrder S; S.init(M, DSA_IN_NP, G, blk);
        pg8::EpiF32 E{(float*)(ws + WS_Z), DSA_IN_NP};
        pg8::gemm_phase<pg8::EpiF32, pg8::StaticOrder, true, true>(lds, g, S, E, tid);
    }
    SEAM(11);
    if (IN(12)) { PH_IDS dsa_norm((const float*)(ws + WS_Z), args.in[10], args.in[11], (bf16_t*)(ws + WS_CQN), (unsigned char*)(ws + WS_CQN8), (bf16_t*)(ws + WS_CKV), (bf16_t*)(ws + WS_KIDX), (float*)(ws + WS_WIDX), gw, NGW, lane); }
    SEAM(12);
    if (IN(13)) { PH_IDS
        { pg8::Gemm g{(const bf16_t*)(ws + WS_CQN8), W_QUP, M, 8192, 512}; pg8::StaticOrder S; S.init(M, 8192, G, blk);
          pg8::EpiBf16Split<QUP_SH> E{(bf16_t*)(ws + WS_QATT), 8192, 0, 0};
          pg8::gemm_phase<pg8::EpiBf16Split<QUP_SH>, pg8::StaticOrder, true, true, 0, true>(lds, g, S, E, tid); }
        { pg8::Gemm g{(const bf16_t*)(ws + WS_CQN), W_QUP + (size_t)4096 * 1024, M, 8192, 1024}; pg8::StaticOrder S; S.init(M, 8192, G, blk);
          pg8::EpiBf16Split<0> E{(bf16_t*)(ws + WS_QIDX), 8192, 0, 0};
          pg8::gemm_phase<pg8::EpiBf16Split<0>, pg8::StaticOrder, true, true>(lds, g, S, E, tid); }
    }
    SEAM(13);
    if (IN(14)) { PH_IDS
        for (int i = 0; i * G < 1024; ++i) { const int u = i * G + ((i & 1) ? (G - 1 - blk) : blk); if (u < 1024) indexer_group(u, (const bf16_t*)(ws + WS_QIDX), (const bf16_t*)(ws + WS_KIDX), (const float*)(ws + WS_WIDX), (float*)(ws + WS_SC), lds, tid); }
        asm volatile("s_waitcnt vmcnt(0)" ::: "memory");
        for (int i = 0; i * G < 1024; ++i) { const int u = i * G + ((i & 1) ? (G - 1 - blk) : blk); if (u < 1024) {
#pragma unroll 1
            for (int tk = 0; tk < 2; ++tk) topk_token(16 * u + 2 * wave + tk, (const float*)(ws + WS_SC), (int*)(ws + WS_SEL), lane); } }
    }
    SEAM(15);
    if (IN(16)) { PH_IDS
        pg8::Gemm g{(const bf16_t*)(ws + WS_QATT), W_UK, M, 32768, 128, 8192}; pg8::StaticOrder S; S.init(M, 32768, G, blk);
        pg8::EpiQLat8 E{(unsigned char*)(ws + WS_QLAT), QL_SC};
        pg8::gemm_phase<pg8::EpiQLat8, pg8::StaticOrder, true, true, 1>(lds, g, S, E, tid);
    }
    SEAM(16);
    if (IN(17)) { PH_IDS
        attn_stream(blk, G, (bf16_t*)(ws + WS_QLAT), (const bf16_t*)(ws + WS_CKV), (const int*)(ws + WS_SEL), lds, tid);
    }
    SEAM(17);
    if (IN(18)) { PH_IDS
        pg8::Gemm g{(const bf16_t*)(ws + WS_QLAT), W_UV, M, 8192, 256, 32768}; pg8::StaticOrder S; S.init(128 * 256, 32 * 256, G, blk);
        pg8::EpiDiag<true> E{(bf16_t*)(ws + WS_QATT), 8192, DSO_SC / (OL_SC * WUV_SC)};
        pg8::gemm_phase<pg8::EpiDiag<true>, pg8::StaticOrder, true, true, 2, true>(lds, g, S, E, tid);
    }
    SEAM(18);
    if (IN(19)) { PH_IDS
        pg8::Gemm g{(const bf16_t*)(ws + WS_QATT), W_DSA_O, M, 4096, 4096}; pg8::StaticOrder S; S.init(M, 4096, G, blk);
        pg8::EpiResBf16<false, DSAO_SH> E{H, H, 4096};
        pg8::gemm_phase<pg8::EpiResBf16<false, DSAO_SH>, pg8::StaticOrder, true, true, 0, true>(lds, g, S, E, tid);
    }
    SEAM(19);
    if (IN(20)) { PH_IDS rmsnorm_rows_from_bf16<2>(H, g_ffn + D, HN, gw, NGW, lane); }
    SEAM(20);
    if (IN(21)) { PH_IDS
        pg8::Gemm g{HN, W_UP + (size_t)DFF2 * 4096, M, DFF2, 2048}; pg8::StaticOrder S; S.init(M, DFF2, G, blk);
        pg8::EpiConvAct<true, UP_SH> E{(bf16_t*)(ws + WS_ACT), (bf16_t*)(ws + WS_U), args.in[17] + (size_t)3 * DFF2, args.in[18] + DFF2};
        pg8::gemm_phase<pg8::EpiConvAct<true, UP_SH>, pg8::StaticOrder, true, true, 0, true>(lds, g, S, E, tid);
    }
    SEAM(21);
    if (IN(22)) { PH_IDS conv_fixup<true>((const bf16_t*)(ws + WS_U), args.in[17] + (size_t)3 * DFF2, args.in[18] + DFF2, (bf16_t*)(ws + WS_ACT), blk * NTHR + tid, G * NTHR); }
    SEAM(22);
    if (IN(23)) { PH_IDS
        pg8::Gemm g{(const bf16_t*)(ws + WS_ACT), W_DN + (size_t)4096 * DFF, M, 4096, DFF / 2, 0}; pg8::StaticOrder S; S.init(M, 4096, G, blk);
        pg8::EpiResBf16<false, DN_SH> E{H, H, 4096};
        pg8::gemm_phase<pg8::EpiResBf16<false, DN_SH>, pg8::StaticOrder, true, true, 0, true>(lds, g, S, E, tid);
    }
    SEAM(23);
    if (IN(24)) { PH_IDS rmsnorm_rows_from_bf16<true>(H, g_final, args.out, gw, NGW, lane); }
#undef IN
#undef SEAM
}

extern "C" void kernel_launch(void* const* d_in, const int* in_sizes, int n_in, void* d_out, int out_size, void* d_ws, size_t ws_size, hipStream_t stream) {
    static int grid = 0;
    if (grid == 0) {
        if (n_in != 20 || in_sizes[0] != M * D || out_size != M * D || ws_size < WS_END) { fprintf(stderr, "kernel_launch: unexpected shapes / workspace (n_in %d, ws %zu < %zu); nothing launched\n", n_in, ws_size, (size_t)WS_END); grid = -1; return; }
        int dev = 0, cus = 0, per_cu = 0;
        if (hipGetDevice(&dev) != hipSuccess || hipDeviceGetAttribute(&cus, hipDeviceAttributeMultiprocessorCount, dev) != hipSuccess) { grid = -1; return; }
        if (hipFuncSetAttribute((const void*)fwd, hipFuncAttributeMaxDynamicSharedMemorySize, LDS_BYTES) != hipSuccess) { fprintf(stderr, "kernel_launch: hipFuncSetAttribute failed\n"); grid = -1; return; }
        if (hipOccupancyMaxActiveBlocksPerMultiprocessor(&per_cu, (const void*)fwd, NTHR, LDS_BYTES) != hipSuccess || per_cu < 1) { fprintf(stderr, "kernel_launch: occupancy query says %d blocks per CU\n", per_cu); }
        (void)hipGetLastError();
        grid = cus;
    }
    if (grid < 0) return;
    if (hipMemsetAsync((char*)d_ws + WS_CTL, 0, CTL_ZERO_BYTES, stream) != hipSuccess) return;
    Args a{};
    for (int i = 0; i < 20; ++i) a.in[i] = (const float*)d_in[i];
    a.out = (float*)d_out; a.ws = (unsigned char*)d_ws;
#if MK_ONE_LAUNCH
    a.ph_lo = 0; a.ph_hi = NPH;
    hipLaunchKernelGGL(fwd, dim3(grid), dim3(NTHR), LDS_BYTES, stream, a);
#else
    for (int p = 0; p < NPH; ++p) { a.ph_lo = p; a.ph_hi = p + 1; hipLaunchKernelGGL(fwd, dim3(grid), dim3(NTHR), LDS_BYTES, stream, a); }
#endif
}
```
